# Optimizing an MI355X kernel written in HIP

```python
import math
import jax
import jax.numpy as jnp
from jax import lax
import numpy as np

D_MODEL = 1024
BATCH = 8
SEQ = 2048
DEPTH = 2
DEC_BATCH = 128
DEC_SEQ = 4
PAST_LEN = 16384
PAGE_SIZE = 128

HEAD_DIM = 128
DN_HEADS = 4
DN_DK = HEAD_DIM
DN_DV = HEAD_DIM
DN_QKV = 2 * DN_HEADS * DN_DK + DN_HEADS * DN_DV
CONV_W = 4
RET_HEADS = 4
RET_DK = HEAD_DIM
RET_DV = HEAD_DIM
RET_WIDTH = RET_HEADS * RET_DV
ROPE_BASE = 10000.0
ML_HEADS = 4
ML_DK = HEAD_DIM
ML_DV = HEAD_DIM
ML_WIDTH = ML_HEADS * ML_DV
D_FF = 4 * D_MODEL
CHUNK = 64
DEEPNORM_ALPHA = (2 * DEPTH) ** 0.25
DEEPNORM_BETA = (8 * DEPTH) ** -0.25
LN_EPS = 1e-5
RMS_EPS = 1e-6
PROJ_SIZES = (DN_QKV, DN_HEADS * DN_DV, DN_HEADS, DN_HEADS,
              RET_HEADS * RET_DK, RET_HEADS * RET_DK, RET_WIDTH, RET_WIDTH,
              ML_HEADS * ML_DK, ML_HEADS * ML_DK, ML_WIDTH, ML_WIDTH, ML_HEADS, ML_HEADS,
              3 * D_MODEL)
PROJ_WIDTH = sum(PROJ_SIZES)

kernel_name = 'hybrid_deltanet_retention_mlstm_step'


def _blocks(a, n, c):
    return a.reshape(a.shape[0], n, c, *a.shape[2:]).swapaxes(2, 3)


def _unblocks(a):
    b, n, h, c, d = a.shape
    return a.swapaxes(2, 3).reshape(b, n * c, h, d)


def _chunk_axis_first(*arrs):
    return tuple(a.swapaxes(0, 1) for a in arrs)


def _rms(x):
    return x * lax.rsqrt(jnp.mean(jnp.square(x), axis=-1, keepdims=True) + RMS_EPS)


def _l2norm(x):
    return x * lax.rsqrt(jnp.sum(jnp.square(x), axis=-1, keepdims=True) + RMS_EPS)


def _layer_norm(x, g, b):
    xf = x.astype(jnp.float32)
    mu = jnp.mean(xf, axis=-1, keepdims=True)
    var = jnp.mean(jnp.square(xf - mu), axis=-1, keepdims=True)
    return ((xf - mu) * lax.rsqrt(var + LN_EPS) * g + b).astype(x.dtype)


def _rotary(x, pos0):
    T, half = x.shape[1], x.shape[-1] // 2
    inv_freq = 1.0 / (ROPE_BASE ** jnp.linspace(0.0, 1.0, half, dtype=jnp.float32))
    pos = (pos0 + jnp.arange(T)).astype(jnp.float32)
    ang = pos[:, None] * inv_freq[None, :]
    cos, sin = jnp.cos(ang)[None, :, None, :], jnp.sin(ang)[None, :, None, :]
    x1, x2 = x[..., :half], x[..., half:]
    return jnp.concatenate([x1 * cos - x2 * sin, x1 * sin + x2 * cos], axis=-1)


def gated_delta_chunked(q, k, v, beta, g, S0):
    T = q.shape[1]
    dv = v.shape[-1]
    C = math.gcd(T, CHUNK)
    N = T // C
    q, k, v = _blocks(q, N, C), _blocks(k, N, C), _blocks(v, N, C)
    beta, g = _blocks(beta, N, C), _blocks(g, N, C)
    gc = jnp.cumsum(g, axis=-1)
    idx = jnp.arange(C)
    causal = idx[:, None] >= idx[None, :]
    strict = idx[:, None] > idx[None, :]
    decay = jnp.exp(jnp.where(causal, gc[..., :, None] - gc[..., None, :], -jnp.inf))
    kb = k * beta[..., None]
    M = jnp.where(strict, jnp.einsum('bnhtk,bnhsk->bnhts', kb, k) * decay, 0.0)
    A = M + jnp.eye(C, dtype=M.dtype)
    rhs = jnp.concatenate([v * beta[..., None], kb * jnp.exp(gc)[..., None]], axis=-1)
    sol = lax.linalg.triangular_solve(A, rhs, left_side=True, lower=True, unit_diagonal=True)
    u, w = sol[..., :dv], sol[..., dv:]
    qk = jnp.einsum('bnhtk,bnhsk->bnhts', q, k) * decay

    def step(S, xs):
        q_c, k_c, u_c, w_c, qk_c, gc_c = xs
        v_new = u_c - jnp.einsum('bhtk,bhkv->bhtv', w_c, S)
        o = (jnp.einsum('bhtk,bhkv->bhtv', q_c * jnp.exp(gc_c)[..., None], S)
             + jnp.einsum('bhts,bhsv->bhtv', qk_c, v_new))
        g_last = gc_c[..., -1]
        S = (S * jnp.exp(g_last)[..., None, None]
             + jnp.einsum('bhsk,bhsv->bhkv', k_c * jnp.exp(g_last[..., None] - gc_c)[..., None], v_new))
        return S, o

    S, o = lax.scan(step, S0, _chunk_axis_first(q, k, u, w, qk, gc))
    return _unblocks(o.swapaxes(0, 1)), S


def retention_chunked(q, k, v, R0):
    T, H = q.shape[1], q.shape[2]
    C = math.gcd(T, CHUNK)
    N = T // C
    q, k, v = _blocks(q, N, C), _blocks(k, N, C), _blocks(v, N, C)
    lg = jnp.log(1.0 - 2.0 ** (-5.0 - jnp.arange(H, dtype=jnp.float32)))
    pos = jnp.arange(C, dtype=jnp.float32)
    causal = pos[:, None] >= pos[None, :]
    dmask = jnp.exp(jnp.where(causal, (pos[:, None] - pos[None, :]) * lg[:, None, None], -jnp.inf))
    o_intra = jnp.einsum('bnhts,bnhsv->bnhtv', jnp.einsum('bnhtk,bnhsk->bnhts', q, k) * dmask, v)
    q_dec = jnp.exp((pos + 1.0) * lg[:, None])
    k_dec = jnp.exp((C - 1.0 - pos) * lg[:, None])
    c_dec = jnp.exp(C * lg)

    def step(R, xs):
        q_c, k_c, v_c = xs
        o_x = jnp.einsum('bhtk,bhkv->bhtv', q_c * q_dec[..., None], R)
        R = R * c_dec[:, None, None] + jnp.einsum('bhsk,bhsv->bhkv', k_c * k_dec[..., None], v_c)
        return R, o_x

    R, o_cross = lax.scan(step, R0, _chunk_axis_first(q, k, v))
    return _unblocks(o_intra + o_cross.swapaxes(0, 1)), R


def mlstm_chunked(q, k, v, i_pre, f_pre, C0, n0, m0):
    T = q.shape[1]
    C = math.gcd(T, CHUNK)
    N = T // C
    q, k, v = _blocks(q, N, C), _blocks(k, N, C), _blocks(v, N, C)
    i_pre, f_pre = _blocks(i_pre, N, C), _blocks(f_pre, N, C)
    F = jnp.cumsum(jax.nn.log_sigmoid(f_pre), axis=-1)
    idx = jnp.arange(C)
    causal = idx[:, None] >= idx[None, :]
    logw = jnp.where(causal, F[..., :, None] - F[..., None, :] + i_pre[..., None, :], -jnp.inf)
    m_intra = F + lax.cummax(i_pre - F, axis=3)
    qk = jnp.einsum('bnhtk,bnhsk->bnhts', q, k)

    def step(carry, xs):
        Cm, nm, mm = carry
        q_c, k_c, v_c, i_c, F_c, logw_c, mi_c, qk_c = xs
        m_t = jnp.maximum(mm[..., None] + F_c, mi_c)
        w_state = jnp.exp(mm[..., None] + F_c - m_t)
        Dm = jnp.exp(logw_c - m_t[..., None]) * qk_c
        num = (w_state[..., None] * jnp.einsum('bhtk,bhkv->bhtv', q_c, Cm)
               + jnp.einsum('bhts,bhsv->bhtv', Dm, v_c))
        den = w_state * jnp.einsum('bhtk,bhk->bht', q_c, nm) + Dm.sum(-1)
        h = num / jnp.maximum(jnp.abs(den), jnp.exp(-m_t))[..., None]
        m_new = m_t[..., -1]
        F_last = F_c[..., -1]
        s_dec = jnp.exp(mm + F_last - m_new)
        kw = k_c * jnp.exp(i_c + F_last[..., None] - F_c - m_new[..., None])[..., None]
        Cm = s_dec[..., None, None] * Cm + jnp.einsum('bhsk,bhsv->bhkv', kw, v_c)
        nm = s_dec[..., None] * nm + kw.sum(-2)
        return (Cm, nm, m_new), h

    (Cm, nm, mm), h = lax.scan(step, (C0, n0, m0),
                               _chunk_axis_first(q, k, v, i_pre, F, logw, m_intra, qk))
    return _unblocks(h.swapaxes(0, 1)), Cm, nm, mm


def trunk_layer(x, pos0, conv_buf, S_dn, R_ret, C_ml, n_ml, m_ml,
                w_in, dn_conv_w, dn_A_log, dn_dt_bias, dn_norm_w, ml_i_bias, ml_f_bias, ml_norm_w,
                w_br_a, w_br_b, w_br_c, w_out, ln1_g, ln1_b, w_ff1, w_ff2, ln2_g, ln2_b):
    bsz, T, _ = x.shape
    f32 = jnp.float32

    def heads(a, h):
        return a.reshape(bsz, T, h, -1).astype(f32)

    proj = jnp.einsum('btd,de->bte', x, w_in)
    split_at = np.cumsum(PROJ_SIZES)[:-1].tolist()
    (a_qkv, a_z, a_beta, a_decay, r_q, r_k, r_v, r_g,
     m_q, m_k, m_v, m_o, m_i, m_f, gates) = jnp.split(proj, split_at, axis=-1)

    xp = jnp.concatenate([conv_buf.astype(a_qkv.dtype), a_qkv], axis=1)
    new_conv = xp[:, T:]
    conv = jax.nn.silu(sum(xp[:, j:j + T] * dn_conv_w[j] for j in range(CONV_W)).astype(f32))
    d_q, d_k, d_v = jnp.split(conv, [DN_HEADS * DN_DK, 2 * DN_HEADS * DN_DK], axis=-1)
    d_q = _l2norm(heads(d_q, DN_HEADS)) * DN_DK ** -0.5
    d_k = _l2norm(heads(d_k, DN_HEADS))
    d_v = heads(d_v, DN_HEADS)
    beta = jax.nn.sigmoid(a_beta.astype(f32))
    g = -jnp.exp(dn_A_log.astype(f32)) * jax.nn.softplus(a_decay.astype(f32) + dn_dt_bias)
    o_a, S_new = gated_delta_chunked(d_q, d_k, d_v, beta, g, S_dn.astype(f32))
    o_a = _rms(o_a) * dn_norm_w * jax.nn.silu(heads(a_z, DN_HEADS))
    o_a = o_a.reshape(bsz, T, DN_HEADS * DN_DV).astype(x.dtype)

    r_qh = _rotary(heads(r_q, RET_HEADS), pos0)
    r_kh = _rotary(heads(r_k, RET_HEADS), pos0) * RET_DK ** -0.5
    o_b, R_new = retention_chunked(r_qh, r_kh, heads(r_v, RET_HEADS), R_ret.astype(f32))
    o_b = (_rms(o_b) * jax.nn.silu(heads(r_g, RET_HEADS))).reshape(bsz, T, RET_WIDTH).astype(x.dtype)

    i_pre = m_i.astype(f32) + ml_i_bias
    f_pre = m_f.astype(f32) + ml_f_bias
    h_c, C_new, n_new, m_new = mlstm_chunked(
        heads(m_q, ML_HEADS), heads(m_k, ML_HEADS) * ML_DK ** -0.5, heads(m_v, ML_HEADS),
        i_pre, f_pre, C_ml.astype(f32), n_ml.astype(f32), m_ml.astype(f32))
    o_c = _rms(h_c).reshape(bsz, T, ML_WIDTH) * ml_norm_w * jax.nn.sigmoid(m_o.astype(f32))
    o_c = o_c.astype(x.dtype)

    g_a, g_b, g_c = jnp.split(jax.nn.sigmoid(gates.astype(f32)).astype(x.dtype), 3, axis=-1)
    merged = g_a * (o_a @ w_br_a) + g_b * (o_b @ w_br_b) + g_c * (o_c @ w_br_c)
    h = _layer_norm(DEEPNORM_ALPHA * x + merged @ w_out, ln1_g, ln1_b)
    ff = jnp.square(jax.nn.relu(h @ w_ff1)) @ w_ff2
    out = _layer_norm(DEEPNORM_ALPHA * h + ff, ln2_g, ln2_b)
    new_states = (new_conv.astype(conv_buf.dtype), S_new.astype(S_dn.dtype), R_new.astype(R_ret.dtype),
                  C_new.astype(C_ml.dtype), n_new.astype(n_ml.dtype), m_new.astype(m_ml.dtype))
    return out, new_states


def setup_inputs(seed: int = 0) -> dict:
    key = jax.random.key(seed)
    ks = iter(jax.random.split(key, 40))
    f32 = jnp.float32
    L = DEPTH
    B = DEEPNORM_BETA

    def nrm(shape, s):
        return s * jax.random.normal(next(ks), shape, f32)

    x_prompt = nrm((BATCH, SEQ, D_MODEL), 1.0)
    x_sample = nrm((DEC_BATCH, DEC_SEQ, D_MODEL), 1.0)
    state_dn_conv = nrm((L, DEC_BATCH, CONV_W - 1, DN_QKV), 1.0)
    state_dn_S = nrm((L, DEC_BATCH, DN_HEADS, DN_DK, DN_DV), 0.1)
    state_ret_R = nrm((L, DEC_BATCH, RET_HEADS, RET_DK, RET_DV), 1.0)
    state_ml_C = nrm((L, DEC_BATCH, ML_HEADS, ML_DK, ML_DV), 0.3)
    state_ml_n = nrm((L, DEC_BATCH, ML_HEADS, ML_DK), 0.3)
    state_ml_m = jax.random.uniform(next(ks), (L, DEC_BATCH, ML_HEADS), f32, 0.0, 4.0)

    segs = [(2 * DN_HEADS * DN_DK, 1.0), (DN_HEADS * DN_DV, B), (DN_HEADS * DN_DV + 2 * DN_HEADS, 1.0),
            (2 * RET_HEADS * RET_DK, 1.0), (RET_WIDTH, B), (RET_WIDTH, 1.0),
            (2 * ML_HEADS * ML_DK, 1.0), (ML_WIDTH, B), (ML_WIDTH + 2 * ML_HEADS + 3 * D_MODEL, 1.0)]
    col_scale = jnp.concatenate([jnp.full((n,), s, f32) for n, s in segs])
    w_in = nrm((L, D_MODEL, PROJ_WIDTH), D_MODEL ** -0.5) * col_scale
    dn_conv_w = nrm((L, CONV_W, DN_QKV), CONV_W ** -0.5)
    dn_A_log = jnp.log(jax.random.uniform(next(ks), (L, DN_HEADS), f32, 1.0, 16.0))
    dt = jnp.exp(jax.random.uniform(next(ks), (L, DN_HEADS), f32, math.log(1e-3), math.log(1e-1)))
    dn_dt_bias = dt + jnp.log(-jnp.expm1(-dt))
    dn_norm_w = 1.0 + nrm((L, DN_DV), 0.02)
    ml_i_bias = nrm((L, ML_HEADS), 0.1)
    ml_f_bias = jnp.linspace(3.0, 6.0, ML_HEADS, dtype=f32) + nrm((L, ML_HEADS), 0.1)
    ml_norm_w = 1.0 + nrm((L, ML_WIDTH), 0.02)
    w_br_a = nrm((L, DN_HEADS * DN_DV, D_MODEL), (DN_HEADS * DN_DV) ** -0.5 * B)
    w_br_b = nrm((L, RET_WIDTH, D_MODEL), RET_WIDTH ** -0.5 * B)
    w_br_c = nrm((L, ML_WIDTH, D_MODEL), ML_WIDTH ** -0.5 * B)
    w_out = nrm((L, D_MODEL, D_MODEL), D_MODEL ** -0.5 * B)
    ln1_g = 1.0 + nrm((L, D_MODEL), 0.02)
    ln1_b = nrm((L, D_MODEL), 0.02)
    w_ff1 = nrm((L, D_MODEL, D_FF), D_MODEL ** -0.5 * B)
    w_ff2 = nrm((L, D_FF, D_MODEL), D_FF ** -0.5 * B)
    ln2_g = 1.0 + nrm((L, D_MODEL), 0.02)
    ln2_b = nrm((L, D_MODEL), 0.02)
    return {'x_prompt': x_prompt, 'x_sample': x_sample,
            'state_dn_conv': state_dn_conv, 'state_dn_S': state_dn_S, 'state_ret_R': state_ret_R,
            'state_ml_C': state_ml_C, 'state_ml_n': state_ml_n, 'state_ml_m': state_ml_m,
            'w_in': w_in, 'dn_conv_w': dn_conv_w, 'dn_A_log': dn_A_log, 'dn_dt_bias': dn_dt_bias,
            'dn_norm_w': dn_norm_w, 'ml_i_bias': ml_i_bias, 'ml_f_bias': ml_f_bias, 'ml_norm_w': ml_norm_w,
            'w_br_a': w_br_a, 'w_br_b': w_br_b, 'w_br_c': w_br_c, 'w_out': w_out,
            'ln1_g': ln1_g, 'ln1_b': ln1_b, 'w_ff1': w_ff1, 'w_ff2': w_ff2, 'ln2_g': ln2_g, 'ln2_b': ln2_b}


def reference(x_prompt, x_sample, state_dn_conv, state_dn_S, state_ret_R, state_ml_C, state_ml_n, state_ml_m,
              w_in, dn_conv_w, dn_A_log, dn_dt_bias, dn_norm_w, ml_i_bias, ml_f_bias, ml_norm_w,
              w_br_a, w_br_b, w_br_c, w_out, ln1_g, ln1_b, w_ff1, w_ff2, ln2_g, ln2_b):
    dt = x_prompt.dtype
    hp, hs = x_prompt, x_sample
    p_states, s_states = [], []
    for l in range(DEPTH):
        weights = (w_in[l], dn_conv_w[l], dn_A_log[l], dn_dt_bias[l], dn_norm_w[l], ml_i_bias[l],
                   ml_f_bias[l], ml_norm_w[l], w_br_a[l], w_br_b[l], w_br_c[l], w_out[l],
                   ln1_g[l], ln1_b[l], w_ff1[l], w_ff2[l], ln2_g[l], ln2_b[l])
        hp, sp = trunk_layer(hp, 0,
                             jnp.zeros((BATCH, CONV_W - 1, DN_QKV), dt),
                             jnp.zeros((BATCH, DN_HEADS, DN_DK, DN_DV), dt),
                             jnp.zeros((BATCH, RET_HEADS, RET_DK, RET_DV), dt),
                             jnp.zeros((BATCH, ML_HEADS, ML_DK, ML_DV), dt),
                             jnp.zeros((BATCH, ML_HEADS, ML_DK), dt),
                             jnp.zeros((BATCH, ML_HEADS), dt),
                             *weights)
        hs, ss = trunk_layer(hs, PAST_LEN, state_dn_conv[l], state_dn_S[l], state_ret_R[l],
                             state_ml_C[l], state_ml_n[l], state_ml_m[l], *weights)
        p_states.append(sp)
        s_states.append(ss)

    def stack(states, i):
        return jnp.stack([s[i] for s in states])

    return (hp, hs,
            stack(p_states, 0), stack(p_states, 1), stack(p_states, 2),
            stack(p_states, 3), stack(p_states, 4), stack(p_states, 5),
            stack(s_states, 0), stack(s_states, 1), stack(s_states, 2),
            stack(s_states, 3), stack(s_states, 4), stack(s_states, 5))
```

```cpp
#include <hip/hip_runtime.h>
#include <hip/hip_cooperative_groups.h>
#include <cstdio>
namespace cg = cooperative_groups;

#define LAS __attribute__((address_space(3)))
typedef unsigned short bf16_t;
typedef short bf16x8 __attribute__((ext_vector_type(8)));
typedef float f32x4 __attribute__((ext_vector_type(4)));
typedef float f32x2 __attribute__((ext_vector_type(2)));
typedef unsigned u32x4 __attribute__((ext_vector_type(4)));
typedef unsigned u32x2 __attribute__((ext_vector_type(2)));

typedef __bf16 bf16x2_t __attribute__((ext_vector_type(2)));
__device__ __forceinline__ unsigned cvt_pk_bf16(float lo, float hi) { const f32x2 v = {lo, hi}; const bf16x2_t b = __builtin_convertvector(v, bf16x2_t); return __builtin_bit_cast(unsigned, b); }
__device__ __forceinline__ bf16_t f2bf(float f) { return (bf16_t)(cvt_pk_bf16(f, 0.f) & 0xffffu); }
__device__ __forceinline__ float bf2f(bf16_t b) { return __uint_as_float(((unsigned)b) << 16); }
__device__ __forceinline__ float bflo(unsigned w) { return __uint_as_float(w << 16); }
__device__ __forceinline__ float bfhi(unsigned w) { return __uint_as_float(w & 0xffff0000u); }
__device__ __forceinline__ float sigmoidf_(float x) { return __builtin_amdgcn_rcpf(1.0f + __expf(-x)); }
__device__ __forceinline__ float siluf_(float x) { return x * __builtin_amdgcn_rcpf(1.0f + __expf(-x)); }
__device__ __forceinline__ float softplusf_(float x) { return fmaxf(x, 0.f) + log1pf(__expf(-fabsf(x))); }
__device__ __forceinline__ float logsigmoidf_(float x) { return fminf(x, 0.f) - log1pf(__expf(-fabsf(x))); }

__device__ __forceinline__ int my_tid() { int t = threadIdx.x; asm volatile("" : "+v"(t)); return t; }
__device__ __forceinline__ int my_bid() { int t = blockIdx.x; asm volatile("" : "+s"(t)); return t; }
__device__ __forceinline__ LAS unsigned char* launder_lds(LAS unsigned char* q) { unsigned v = (unsigned)(unsigned long long)q; asm volatile("" : "+s"(v)); return (LAS unsigned char*)(unsigned long long)v; }
constexpr int NP = 16384, NTOK = 16896, DM = 1024, PW = 6144, NG = 3072, DFF = 4096, NL = 2, SEQ = 2048, NB = 8, NDB = 128;
constexpr float ALPHA = 1.41421356237f;
constexpr float DKS = 0.08838834764831845f;
enum { I_XP = 0, I_XS, I_SCONV, I_SS, I_SR, I_SC, I_SN, I_SM, I_WIN, I_CONVW, I_ALOG, I_DTB, I_DNW, I_IB, I_FB, I_MLW, I_WBA, I_WBB, I_WBC, I_WOUT, I_LN1G, I_LN1B, I_WFF1, I_WFF2, I_LN2G, I_LN2B };
constexpr long O_YP = 0, O_YS = O_YP + (long)NP * DM, O_PCONV = O_YS + 512L * DM, O_PS = O_PCONV + 2L * 8 * 3 * 1536, O_PR = O_PS + 2L * 8 * 4 * 16384, O_PC = O_PR + 2L * 8 * 4 * 16384,
               O_PN = O_PC + 2L * 8 * 4 * 16384, O_PM = O_PN + 2L * 8 * 4 * 128, O_SCONV = O_PM + 2L * 8 * 4, O_SS = O_SCONV + 2L * 128 * 3 * 1536, O_SR = O_SS + 2L * 128 * 4 * 16384,
               O_SC = O_SR + 2L * 128 * 4 * 16384, O_SN = O_SC + 2L * 128 * 4 * 16384, O_SM = O_SN + 2L * 128 * 4 * 128, O_END = O_SM + 2L * 128 * 4;
static_assert(O_END == 72172608L, "output size");
constexpr size_t WS_WIN = 0, SZ_WIN = (size_t)NL * 9216 * 1024 * 2;
constexpr size_t WS_WBR = WS_WIN + SZ_WIN, SZ_WBR = (size_t)NL * 3 * 1024 * 512 * 2;
constexpr size_t WS_WOUT = WS_WBR + SZ_WBR, SZ_WOUT = (size_t)NL * 1024 * 1024 * 2;
constexpr size_t WS_WFF1 = WS_WOUT + SZ_WOUT, SZ_WFF = (size_t)NL * 4096 * 1024 * 2;
constexpr size_t WS_WFF2 = WS_WFF1 + SZ_WFF;
constexpr size_t WS_X = WS_WFF2 + SZ_WFF, SZ_X = (size_t)NTOK * DM * 2;
constexpr size_t WS_PROJ = WS_X + SZ_X, SZ_PROJ = (size_t)NTOK * PW * 2;
constexpr size_t WS_AUX = WS_PROJ + SZ_PROJ, SZ_AUX = (size_t)80 * 1024 * 1024;
constexpr size_t WS_SMALL = WS_AUX + SZ_AUX, SZ_SMALL = (size_t)NTOK * 16 * 4;
constexpr size_t WS_ROPE = WS_SMALL + SZ_SMALL, SZ_ROPE = (size_t)2052 * 64 * 2 * 4;
constexpr size_t WS_CTR = WS_ROPE + SZ_ROPE, SZ_CTR = 16384;
constexpr size_t WS_SGS = WS_CTR + SZ_CTR, SZ_SGS = (size_t)512 * 3072;
constexpr size_t WS_TS1 = WS_SGS + SZ_SGS, SZ_TSLAB = (size_t)512 * 1024 * 4;
constexpr size_t WS_TS2 = WS_TS1 + 4 * SZ_TSLAB;
constexpr size_t WS_END = WS_TS2 + 8 * SZ_TSLAB;
static_assert(WS_END <= (size_t)439575680, "workspace");
constexpr size_t OFF_T2 = (size_t)NTOK * DFF * 2;
static_assert(OFF_T2 + (size_t)NTOK * DM * 4 <= SZ_PROJ, "T2 fits");
constexpr size_t AUX_W = 0, AUX_UT = AUX_W + (size_t)1024 * 16384, AUX_QG = AUX_UT + (size_t)1024 * 16384, AUX_KDT = AUX_QG + (size_t)1024 * 16384, AUX_QK = AUX_KDT + (size_t)1024 * 16384, AUX_EG = AUX_QK + (size_t)1024 * 8192;
static_assert(AUX_EG + 4096 <= SZ_AUX, "aux");

constexpr int LDS_BYTES = 131072 + 1024;
constexpr int MISC_OFF = 131072;

struct Params { const float* in[26]; float* out; unsigned char* ws; };
__device__ __forceinline__ unsigned long long ld_uniform64(const LAS unsigned long long* a) { const unsigned long long v = *a; const unsigned lo = __builtin_amdgcn_readfirstlane((unsigned)v), hi = __builtin_amdgcn_readfirstlane((unsigned)(v >> 32)); return ((unsigned long long)hi << 32) | lo; }
struct DP { const LAS unsigned long long* tab;
    __device__ __forceinline__ const float* in(int i) const { return (const float*)(const __attribute__((address_space(1))) float*)ld_uniform64(tab + i); }
    __device__ __forceinline__ float* out() const { return (float*)(__attribute__((address_space(1))) float*)ld_uniform64(tab + 26); }
    __device__ __forceinline__ unsigned char* ws() const { return (unsigned char*)(__attribute__((address_space(1))) unsigned char*)ld_uniform64(tab + 27); } };
namespace pg8 {
constexpr int BM = 256, BK = 64, HALF = 128, HTB = HALF * BK * 2, STAGE_BYTES = 8 * HTB, NXCD = 8, WGM = 8;
__host__ __device__ __forceinline__ int lds_byte(int r, int c) { const int st = (r >> 4) * 2 + (c >> 5), rr = r & 15, cc = c & 31, ob = rr * 64 + cc * 2; return st * 1024 + (ob ^ (((ob >> 9) & 1) << 5)); }
__host__ __device__ __forceinline__ void stage_rc(int b, int& R, int& C) { const int st = b / 1024, sb = b % 1024, swz = sb ^ (((sb >> 9) & 1) << 5); R = (st >> 1) * 16 + swz / 64; C = (st & 1) * 32 + (swz % 64) / 2; }
__host__ __device__ __forceinline__ int perm32(int rho) { const int n = rho >> 4, i = rho & 15; return 8 * (i >> 2) + 4 * n + (i & 3); }

struct Unit { int pm, pn, z, kind, nt; };
struct Gemm { const bf16_t* A; const bf16_t* Bt; int M, N, K, lda; long zA, zB; int ldb; const bf16_t* A2; long zA2; int kdiv; };

struct Order {
    int nM, nN, nz, nwg, G, c, ntf, ksplit, ntp;
    __device__ void init(int M, int N, int nz_, int G_, int c_, int K, int ksplit_ = 0, int ntp_ = 0) { nM = M / BM; nN = N / BM; nz = nz_; nwg = nM * nN; G = G_; c = c_; ntf = K / BK; ksplit = ksplit_; ntp = ntp_; }
    __device__ bool next(int i, Unit& u) const {
        long L;
        if (ksplit == 0) { const int ti = i / nz; u.z = i - ti * nz; u.kind = 0; u.nt = ntf; L = (long)ti * G + c; if (c < 0 || L >= nwg) return false; }
        else {
            if (ksplit > 0) {
                if (i == 0) { u.z = 0; u.kind = 0; u.nt = ntf; L = c; }
                else if (i == 1 && c < 8 * ksplit) { const int j = c / ksplit; u.z = c - j * ksplit; u.kind = 1; u.nt = ntp; u.pm = 64 + (j >> 2); u.pn = j & 3; return true; }
                else return false;
            } else {
                if (i < nz) { u.z = i; u.kind = 0; u.nt = ntf; L = c; }
                else if (i == nz && c < 8 * nz) { const int j = c / nz; u.z = c - j * nz; u.kind = 2; u.nt = ntf; u.pm = 64 + (j >> 2); u.pn = j & 3; return true; }
                else return false;
            }
            int wgid = (int)L; { const int nw = 256, q = nw / NXCD, xcd = wgid % NXCD, off = wgid / NXCD; wgid = xcd * q + off; }
            const int nig = WGM * 4, gid = wgid / nig, fm = gid * WGM;
            u.pm = fm + ((wgid % nig) % WGM); u.pn = (wgid % nig) / WGM; return true;
        }
        int wgid = (int)L; { const int q = nwg / NXCD, r = nwg % NXCD, xcd = wgid % NXCD, off = wgid / NXCD; wgid = (xcd < r ? xcd * (q + 1) : r * (q + 1) + (xcd - r) * q) + off; }
        const int nig = WGM * nN, gid = wgid / nig, fm = gid * WGM, gsz = (nM - fm) < WGM ? (nM - fm) : WGM;
        u.pm = fm + ((wgid % nig) % gsz); u.pn = (wgid % nig) / gsz; return true;
    }
};

template <class Epi>
__device__ __forceinline__ void gemm_phase(LAS unsigned char* lds, const Gemm g, const Order& S, const Epi& E) {
    lds = launder_lds(lds);
    int tid_l = threadIdx.x; asm volatile("" : "+v"(tid_l));
    const int tid = tid_l, wid = __builtin_amdgcn_readfirstlane(tid >> 6), lane = tid & 63, wr = wid >> 2, wc = wid & 3, fr = lane & 15, fq = lane >> 4;
    const int K = g.ldb, lda = g.lda;
    unsigned voffA[2], voffB[2];
#pragma unroll
    for (int i = 0; i < 2; ++i) { int R, C; stage_rc(tid * 16 + i * 8192, R, C); const int Rb = Epi::PERM ? ((R & ~31) + perm32(R & 31)) : R;
        voffA[i] = (unsigned)(R * lda + C) * 2u; voffB[i] = (unsigned)(Rb * K + C) * 2u; }
    const size_t kstep = (size_t)(BK * 2);
    const size_t hstepA = (size_t)HALF * lda * 2, hstepB = (size_t)HALF * K * 2;
    const size_t tstepA = 2 * hstepA, tstepB = 2 * hstepB;
    const unsigned ldsw = (unsigned)wid * 1024u;
    const int aoff = lds_byte(wr * 64 + fr, fq * 8), boff = lds_byte(wc * 32 + fr, fq * 8);
#define PG8_SA(b, h) (((b) * 2 + (h)) * HTB)
#define PG8_SB(b, h) ((4 + (b) * 2 + (h)) * HTB)
#define PG8_STAGE(bufoff, gbase, voff) do { _Pragma("unroll") for (int _i = 0; _i < 2; ++_i) \
        __builtin_amdgcn_global_load_lds((const unsigned*)((const char*)(gbase) + (voff)[_i]), (LAS unsigned*)(lds + (bufoff) + ldsw + _i * 8192), 16, 0, 0); } while (0)
#define PG8_LDA(dst, b, h) do { _Pragma("unroll") for (int m = 0; m < 4; ++m) _Pragma("unroll") for (int k = 0; k < 2; ++k) dst[m][k] = *(const LAS bf16x8*)(lds + PG8_SA(b, h) + aoff + m * 2048 + k * 1024); } while (0)
#define PG8_LDB(dst, b, h) do { _Pragma("unroll") for (int n = 0; n < 2; ++n) _Pragma("unroll") for (int k = 0; k < 2; ++k) dst[n][k] = *(const LAS bf16x8*)(lds + PG8_SB(b, h) + boff + n * 2048 + k * 1024); } while (0)
#define PG8_MMA(ai, bj, At, Bt) do { __builtin_amdgcn_s_setprio(1); _Pragma("unroll") for (int m = 0; m < 4; ++m) _Pragma("unroll") for (int n = 0; n < 2; ++n) _Pragma("unroll") for (int k = 0; k < 2; ++k) \
        acc[ai][bj][m][n] = __builtin_amdgcn_mfma_f32_16x16x32_bf16(Bt[n][k], At[m][k], acc[ai][bj][m][n], 0, 0, 0); __builtin_amdgcn_s_setprio(0); } while (0)
#define PG8_WAIT_V(n) asm volatile("s_waitcnt vmcnt(" #n ")" ::: "memory")
#define PG8_WAIT_L(n) asm volatile("s_waitcnt lgkmcnt(" #n ")" ::: "memory")
#define PG8_BAR __builtin_amdgcn_s_barrier()
#define PG8_SCHED __builtin_amdgcn_sched_barrier(0)
    Unit cur, nxt; int ui = 0;
    if (!S.next(0, cur)) return;
    int nt = cur.nt;
    f32x4 acc[2][2][4][2];
#pragma unroll
    for (int a = 0; a < 2; ++a)
#pragma unroll
        for (int b = 0; b < 2; ++b)
#pragma unroll
            for (int m = 0; m < 4; ++m)
#pragma unroll
                for (int n = 0; n < 2; ++n) acc[a][b][m][n] = (f32x4){0.f, 0.f, 0.f, 0.f};
    bf16x8 At[4][2], B0[2][2], B1[2][2];
#define PG8_APTR(u_) ((u_).kind == 1 ? (const char*)(g.A2 + (size_t)((u_).z / g.kdiv) * g.zA2 + (size_t)((u_).z % g.kdiv) * g.zA) + (size_t)((u_).pm - 64) * tstepA : (const char*)(g.A + (size_t)(u_).z * g.zA) + (size_t)(u_).pm * tstepA)
#define PG8_BPTR(u_) ((const char*)(g.Bt + (size_t)((u_).kind == 1 ? (u_).z % g.kdiv : (u_).z) * g.zB) + (size_t)(u_).pn * tstepB)
    const char* cA = PG8_APTR(cur); const char* cB = PG8_BPTR(cur);
    PG8_STAGE(PG8_SB(0, 0), cB, voffB); PG8_STAGE(PG8_SA(0, 0), cA, voffA); PG8_STAGE(PG8_SB(0, 1), cB + hstepB, voffB); PG8_STAGE(PG8_SA(0, 1), cA + hstepA, voffA);
    if (wr == 1) PG8_BAR;
    PG8_WAIT_V(4); PG8_BAR;
    PG8_STAGE(PG8_SB(1, 0), cB + kstep, voffB); PG8_STAGE(PG8_SA(1, 0), cA + kstep, voffA); PG8_STAGE(PG8_SB(1, 1), cB + hstepB + kstep, voffB);
    PG8_WAIT_V(6); PG8_BAR;
    for (;;) {
        const bool has_next = S.next(ui + 1, nxt);
        const char* nA = has_next ? PG8_APTR(nxt) : cA; const char* nB = has_next ? PG8_BPTR(nxt) : cB;
        for (int t = 0; t < nt; t += 2) {
            const bool last = (t == nt - 2);
            const char* a1 = cA + (size_t)(t + 1) * kstep;
            const char* a2 = last ? nA : cA + (size_t)(t + 2) * kstep; const char* b2 = last ? nB : cB + (size_t)(t + 2) * kstep;
            const char* a3 = a2 + kstep; const char* b3 = b2 + kstep;
            PG8_LDB(B0, 0, 0); PG8_SCHED; PG8_LDA(At, 0, 0); PG8_STAGE(PG8_SA(1, 1), a1 + hstepA, voffA);
            PG8_WAIT_L(8); PG8_BAR; PG8_WAIT_L(0); PG8_MMA(0, 0, At, B0); PG8_BAR; PG8_SCHED;
            PG8_LDB(B1, 0, 1); PG8_STAGE(PG8_SB(0, 0), b2, voffB);
            PG8_BAR; PG8_WAIT_L(0); PG8_MMA(0, 1, At, B1); PG8_BAR;
            PG8_LDA(At, 0, 1); PG8_STAGE(PG8_SA(0, 0), a2, voffA);
            PG8_BAR; PG8_WAIT_L(0); PG8_MMA(1, 0, At, B0); PG8_BAR; PG8_SCHED;
            PG8_STAGE(PG8_SB(0, 1), b2 + hstepB, voffB);
            PG8_WAIT_V(6); PG8_BAR; PG8_MMA(1, 1, At, B1); PG8_BAR;
            PG8_LDB(B0, 1, 0); PG8_SCHED; PG8_LDA(At, 1, 0); PG8_STAGE(PG8_SA(0, 1), a2 + hstepA, voffA);
            PG8_WAIT_L(8); PG8_BAR; PG8_WAIT_L(0); PG8_MMA(0, 0, At, B0); PG8_BAR; PG8_SCHED;
            PG8_LDB(B1, 1, 1); PG8_STAGE(PG8_SB(1, 0), b3, voffB);
            PG8_BAR; PG8_WAIT_L(0); PG8_MMA(0, 1, At, B1); PG8_BAR;
            PG8_LDA(At, 1, 1); PG8_STAGE(PG8_SA(1, 0), a3, voffA);
            PG8_BAR; PG8_WAIT_L(0); PG8_MMA(1, 0, At, B0); PG8_BAR; PG8_SCHED;
            PG8_STAGE(PG8_SB(1, 1), b3 + hstepB, voffB);
            PG8_WAIT_V(6); PG8_BAR; PG8_MMA(1, 1, At, B1); PG8_BAR;
        }
        E(acc, cur, wr, wc, fr, fq);
        if (!has_next) break;
#pragma unroll
        for (int a = 0; a < 2; ++a)
#pragma unroll
            for (int b = 0; b < 2; ++b)
#pragma unroll
                for (int m = 0; m < 4; ++m)
#pragma unroll
                    for (int n = 0; n < 2; ++n) acc[a][b][m][n] = (f32x4){0.f, 0.f, 0.f, 0.f};
        cur = nxt; cA = nA; cB = nB; ++ui; nt = cur.nt;
    }
    PG8_WAIT_V(0);
    if (wr == 0) PG8_BAR;
    PG8_BAR;
#undef PG8_APTR
#undef PG8_BPTR
#undef PG8_SA
#undef PG8_SB
#undef PG8_STAGE
#undef PG8_LDA
#undef PG8_LDB
#undef PG8_MMA
#undef PG8_WAIT_V
#undef PG8_WAIT_L
#undef PG8_BAR
#undef PG8_SCHED
}
}
namespace pg8 {
template <int ACT  > struct EpiBf16 {
    static constexpr bool PERM = true;
    bf16_t* O; int ldc;
    __device__ __forceinline__ void operator()(const f32x4 (&acc)[2][2][4][2], const Unit& u, int wr, int wc, int fr, int fq) const {
        const int row0 = u.pm * BM + wr * 64 + fr;
        int colt = u.pn * BM; if (ACT == 2) colt = (u.pn >> 2) * 2048 + (u.pn & 3) * 256;
        const int col0 = colt + wc * 32 + 8 * fq;
#pragma unroll
        for (int ai = 0; ai < 2; ++ai)
#pragma unroll
            for (int m = 0; m < 4; ++m) { bf16_t* rowp = O + (size_t)(row0 + ai * HALF + m * 16) * ldc + col0;
#pragma unroll
                for (int bj = 0; bj < 2; ++bj) { f32x4 v0 = acc[ai][bj][m][0], v1 = acc[ai][bj][m][1];
                    if (ACT == 1) {
#pragma unroll
                        for (int j = 0; j < 4; ++j) { const float a = fmaxf(v0[j], 0.f), b = fmaxf(v1[j], 0.f); v0[j] = a * a; v1[j] = b * b; } }
                    if (ACT == 2) {
#pragma unroll
                        for (int j = 0; j < 4; ++j) { v0[j] = sigmoidf_(v0[j]); v1[j] = sigmoidf_(v1[j]); } }
                    u32x4 w; w.x = cvt_pk_bf16(v0[0], v0[1]); w.y = cvt_pk_bf16(v0[2], v0[3]); w.z = cvt_pk_bf16(v1[0], v1[1]); w.w = cvt_pk_bf16(v1[2], v1[3]);
                    *(u32x4*)(rowp + bj * HALF) = w; } }
    }
};
struct EpiGateU8 {
    static constexpr bool PERM = true;
    unsigned char* SG8; unsigned char* SGS;
    __device__ __forceinline__ void operator()(const f32x4 (&acc)[2][2][4][2], const Unit& u, int wr, int wc, int fr, int fq) const {
        const int row0 = u.pm * BM + wr * 64 + fr, col0 = u.pn * BM + wc * 32 + 8 * fq; const bool smp = u.pm >= 64;
#pragma unroll
        for (int ai = 0; ai < 2; ++ai)
#pragma unroll
            for (int m = 0; m < 4; ++m) { const size_t rr = (size_t)(row0 + ai * HALF + m * 16); unsigned char* rowp = smp ? SGS + (rr - NP) * 3072 + col0 : SG8 + rr * (PW * 2) + col0;
#pragma unroll
                for (int bj = 0; bj < 2; ++bj) { const f32x4 v0 = acc[ai][bj][m][0], v1 = acc[ai][bj][m][1]; unsigned q[8];
#pragma unroll
                    for (int j = 0; j < 4; ++j) { q[j] = (unsigned)(sigmoidf_(v0[j]) * 255.0f + 0.5f); q[4 + j] = (unsigned)(sigmoidf_(v1[j]) * 255.0f + 0.5f); }
                    u32x2 w; w.x = q[0] | (q[1] << 8) | (q[2] << 16) | (q[3] << 24); w.y = q[4] | (q[5] << 8) | (q[6] << 16) | (q[7] << 24);
                    *(u32x2*)(rowp + bj * HALF) = w; } }
    }
};
struct EpiMerge {
    static constexpr bool PERM = true;
    const unsigned char* SG8; const unsigned char* SGS; bf16_t* MG; bf16_t* P;
    __device__ __forceinline__ void operator()(const f32x4 (&acc)[2][2][4][2], const Unit& u, int wr, int wc, int fr, int fq) const {
        const int row0 = u.pm * BM + wr * 64 + fr, col0 = u.pn * BM + wc * 32 + 8 * fq; const bool smp = u.pm >= 64;
        const float S8 = 1.0f / 255.0f;
#pragma unroll
        for (int ai = 0; ai < 2; ++ai) {
            u32x2 sgv[4][2]; u32x4 pvv[4][2];
#pragma unroll
            for (int m = 0; m < 4; ++m) { const size_t r = (size_t)(row0 + ai * HALF + m * 16);
#pragma unroll
                for (int bj = 0; bj < 2; ++bj) { const int c = col0 + bj * HALF;
                    sgv[m][bj] = *(const u32x2*)(smp ? SGS + (r - NP) * 3072 + u.z * 1024 + c : SG8 + r * (PW * 2) + u.z * 1024 + c);
                    pvv[m][bj] = (u32x4){0u, 0u, 0u, 0u}; if (u.z > 0 && u.kind == 0) pvv[m][bj] = *(const u32x4*)(MG + r * DM + c); } }
#pragma unroll
            for (int m = 0; m < 4; ++m) { const size_t r = (size_t)(row0 + ai * HALF + m * 16);
#pragma unroll
                for (int bj = 0; bj < 2; ++bj) { const int c = col0 + bj * HALF; const u32x2 sg = sgv[m][bj]; const u32x4 pv = pvv[m][bj];
                    const f32x4 v0 = acc[ai][bj][m][0], v1 = acc[ai][bj][m][1];
                    float o[8];
                    o[0] = bflo(pv.x) + (float)(sg.x & 255u) * S8 * v0[0]; o[1] = bfhi(pv.x) + (float)((sg.x >> 8) & 255u) * S8 * v0[1]; o[2] = bflo(pv.y) + (float)((sg.x >> 16) & 255u) * S8 * v0[2]; o[3] = bfhi(pv.y) + (float)(sg.x >> 24) * S8 * v0[3];
                    o[4] = bflo(pv.z) + (float)(sg.y & 255u) * S8 * v1[0]; o[5] = bfhi(pv.z) + (float)((sg.y >> 8) & 255u) * S8 * v1[1]; o[6] = bflo(pv.w) + (float)((sg.y >> 16) & 255u) * S8 * v1[2]; o[7] = bfhi(pv.w) + (float)(sg.y >> 24) * S8 * v1[3];
                    u32x4 w; w.x = cvt_pk_bf16(o[0], o[1]); w.y = cvt_pk_bf16(o[2], o[3]); w.z = cvt_pk_bf16(o[4], o[5]); w.w = cvt_pk_bf16(o[6], o[7]);
                    if (u.kind == 2) *(u32x4*)(P + (size_t)u.z * (512 * 1024) + (r - NP) * DM + c) = w; else *(u32x4*)(MG + r * DM + c) = w; } }
        }
    }
};
struct EpiRes {
    static constexpr bool PERM = true;
    const bf16_t* R; bf16_t* T; float* TS;
    __device__ __forceinline__ void operator()(const f32x4 (&acc)[2][2][4][2], const Unit& u, int wr, int wc, int fr, int fq) const {
        const int row0 = u.pm * BM + wr * 64 + fr, col0 = u.pn * BM + wc * 32 + 8 * fq;
        const float al = (u.kind == 0 || u.z == 0) ? ALPHA : 0.f;
        u32x4 rv[8][2];
#pragma unroll
        for (int g = 0; g < 8; ++g) { const size_t off = (size_t)(row0 + (g >> 2) * HALF + (g & 3) * 16) * DM + col0;
#pragma unroll
            for (int bj = 0; bj < 2; ++bj) rv[g][bj] = *(const u32x4*)(R + off + bj * HALF); }
#pragma unroll
        for (int g = 0; g < 8; ++g) { const int ai = g >> 2, m = g & 3; const size_t off = (size_t)(row0 + ai * HALF + m * 16) * DM + col0;
#pragma unroll
            for (int bj = 0; bj < 2; ++bj) { const f32x4 a0 = acc[ai][bj][m][0], a1 = acc[ai][bj][m][1]; const u32x4 r4 = rv[g][bj];
                f32x4 o0, o1;
                o0[0] = al * bflo(r4.x) + a0[0]; o0[1] = al * bfhi(r4.x) + a0[1]; o0[2] = al * bflo(r4.y) + a0[2]; o0[3] = al * bfhi(r4.y) + a0[3];
                o1[0] = al * bflo(r4.z) + a1[0]; o1[1] = al * bfhi(r4.z) + a1[1]; o1[2] = al * bflo(r4.w) + a1[2]; o1[3] = al * bfhi(r4.w) + a1[3];
                if (u.kind == 1) { float* tp = TS + (size_t)u.z * (512 * 1024) - (size_t)NP * DM + off + bj * HALF; *(f32x4*)tp = o0; *(f32x4*)(tp + 4) = o1; }
                else { u32x4 w; w.x = cvt_pk_bf16(o0[0], o0[1]); w.y = cvt_pk_bf16(o0[2], o0[3]); w.z = cvt_pk_bf16(o1[0], o1[1]); w.w = cvt_pk_bf16(o1[2], o1[3]); *(u32x4*)(T + off + bj * HALF) = w; } } }
    }
};
}
__device__ const double INVF_TAB[64] = {1.0, 0.8639884421904872, 0.7464760282387446, 0.6449466718349793, 0.5572264607350911, 0.4814372300171723, 0.4159562095110165, 0.35938136364028433, 0.3105013285433559, 0.26826956374857486, 0.2317818064466077, 0.20025680531542636, 0.1730195682307726, 0.14948690978871287, 0.12915496453195024, 0.11158839852149276, 0.09641107502718904, 0.083298055951679, 0.07196855883385066, 0.062180004100288046, 0.05372280579965271, 0.04641588408923615, 0.04010278807514057, 0.03464834599094895, 0.029935770990762976, 0.02586416058779556, 0.022346336198178787, 0.019306976531752063, 0.016681004863249332, 0.01441219565322053, 0.012451970684591487, 0.010758358938547867, 0.009295095387898274, 0.008030855121976314, 0.006938566125329044, 0.005994841040503793, 0.005179473460621423, 0.004475005283380656, 0.0038663529099118386, 0.003340484284901384, 0.002886139862987199, 0.0024935915269452234, 0.002154434295785405, 0.0018614063629509262, 0.0016082336113996364, 0.0013894952764291722, 0.0012005078799085084, 0.0010372249507937684, 0.0008961503848114063, 0.0007742635882245655, 0.0006689548029112771, 0.0005779692279785651, 0.0004993587414820355, 0.0004314401885488794, 0.00037275934279762493, 0.00032205976942079685, 0.0002782559232477479, 0.00024040990578147253, 0.00020771138354670873, 0.00017946023777449892, 0.00015505157392992585, 0.00013396277011711087, 0.00011574228705063282, 0.0001};
struct TileDesc { const float* src; bf16_t* dst; int ldsrc, ldd; };
__device__ __forceinline__ TileDesc prep_tile(const DP& p, int j) {
    TileDesc d;
    if (j < 4608) { const int l = j / 2304, rem = j % 2304, kt = rem & 15, nt = rem >> 4; const int n0 = nt * 64;
        const int c0 = n0 < 2048 ? n0 : (n0 < 6144 ? n0 + 8 : n0 + 16);
        d.src = p.in(I_WIN) + (size_t)l * 1024 * 9232 + (size_t)(kt * 64) * 9232 + c0; d.ldsrc = 9232; d.dst = (bf16_t*)(p.ws() + WS_WIN) + (size_t)l * 9216 * 1024 + (size_t)n0 * 1024 + kt * 64; d.ldd = 1024; }
    else if (j < 5376) { const int idx = j - 4608, l = idx / 384, rem = idx % 384, b = rem / 128, rem2 = rem % 128, kt = rem2 & 7, nt = rem2 >> 3;
        d.src = p.in(I_WBA + b) + (size_t)l * 512 * 1024 + (size_t)(kt * 64) * 1024 + nt * 64; d.ldsrc = 1024; d.dst = (bf16_t*)(p.ws() + WS_WBR) + (size_t)(l * 3 + b) * 1024 * 512 + (size_t)(nt * 64) * 512 + kt * 64; d.ldd = 512; }
    else if (j < 5888) { const int idx = j - 5376, l = idx / 256, rem = idx % 256, kt = rem & 15, nt = rem >> 4;
        d.src = p.in(I_WOUT) + (size_t)l * 1024 * 1024 + (size_t)(kt * 64) * 1024 + nt * 64; d.ldsrc = 1024; d.dst = (bf16_t*)(p.ws() + WS_WOUT) + (size_t)l * 1024 * 1024 + (size_t)(nt * 64) * 1024 + kt * 64; d.ldd = 1024; }
    else if (j < 7936) { const int idx = j - 5888, l = idx / 1024, rem = idx % 1024, kt = rem & 15, nt = rem >> 4;
        d.src = p.in(I_WFF1) + (size_t)l * 1024 * 4096 + (size_t)(kt * 64) * 4096 + nt * 64; d.ldsrc = 4096; d.dst = (bf16_t*)(p.ws() + WS_WFF1) + (size_t)l * 4096 * 1024 + (size_t)(nt * 64) * 1024 + kt * 64; d.ldd = 1024; }
    else { const int idx = j - 7936, l = idx / 1024, rem = idx % 1024, kt = rem & 63, nt = rem >> 6;
        d.src = p.in(I_WFF2) + (size_t)l * 4096 * 1024 + (size_t)(kt * 64) * 1024 + nt * 64; d.ldsrc = 1024; d.dst = (bf16_t*)(p.ws() + WS_WFF2) + (size_t)l * 1024 * 4096 + (size_t)(nt * 64) * 4096 + kt * 64; d.ldd = 4096; }
    return d;
}
__device__ __forceinline__ int layer_tile(int l, int i) {
    if (i < 2304) return l * 2304 + i;
    if (i < 2688) return 4608 + l * 384 + (i - 2304);
    if (i < 2944) return 5376 + l * 256 + (i - 2688);
    if (i < 3968) return 5888 + l * 1024 + (i - 2944);
    return 7936 + l * 1024 + (i - 3968);
}
__device__ void prep_one_tile(const DP& p, int j, LAS unsigned char* lds) {
    lds = launder_lds(lds);
    LAS float* b = (LAS float*)lds; const int tid = my_tid();
    const TileDesc d = prep_tile(p, j);
    float cur[8];
#pragma unroll
    for (int i = 0; i < 8; ++i) { const int idx = tid + i * 512, r = idx >> 6, c = idx & 63; cur[i] = d.src[(size_t)r * d.ldsrc + c]; }
    __syncthreads();
#pragma unroll
    for (int i = 0; i < 8; ++i) { const int idx = tid + i * 512, r = idx >> 6, c = idx & 63; b[r * 65 + c] = cur[i]; }
    __syncthreads();
#pragma unroll
    for (int i = 0; i < 4; ++i) { const int idx = tid + i * 512, n = idx >> 5, kp = idx & 31;
        *(unsigned*)(d.dst + (size_t)n * d.ldd + 2 * kp) = cvt_pk_bf16(b[(2 * kp) * 65 + n], b[(2 * kp + 1) * 65 + n]); }
}
__device__ void phase_prep(const DP& p, LAS unsigned char* lds) {
    lds = launder_lds(lds);
    LAS float* buf = (LAS float*)lds;
    const int G = gridDim.x, tid0 = my_tid(), bid0 = my_bid();
    const int tid = tid0;
    float cur[8]; TileDesc dc, dn; int par = 0;
    if (bid0 < 4992) { dc = prep_tile(p, layer_tile(0, bid0));
#pragma unroll
        for (int i = 0; i < 8; ++i) { const int idx = tid + i * 512, r = idx >> 6, c = idx & 63; cur[i] = dc.src[(size_t)r * dc.ldsrc + c]; } }
    for (int j = bid0; j < 4992; j += G) {
        float nxt[8]; const bool hn = j + G < 4992;
        if (hn) { dn = prep_tile(p, layer_tile(0, j + G));
#pragma unroll
            for (int i = 0; i < 8; ++i) { const int idx = tid + i * 512, r = idx >> 6, c = idx & 63; nxt[i] = dn.src[(size_t)r * dn.ldsrc + c]; } }
        LAS float* b = buf + par * (64 * 65);
#pragma unroll
        for (int i = 0; i < 8; ++i) { const int idx = tid + i * 512, r = idx >> 6, c = idx & 63; b[r * 65 + c] = cur[i]; }
        __syncthreads();
#pragma unroll
        for (int i = 0; i < 4; ++i) { const int idx = tid + i * 512, n = idx >> 5, kp = idx & 31;
            *(unsigned*)(dc.dst + (size_t)n * dc.ldd + 2 * kp) = cvt_pk_bf16(b[(2 * kp) * 65 + n], b[(2 * kp + 1) * 65 + n]); }
        if (hn) {
#pragma unroll
            for (int i = 0; i < 8; ++i) cur[i] = nxt[i];
            dc = dn; }
        par ^= 1;
    }
    __syncthreads();
    const size_t gtid = (size_t)bid0 * 512 + tid0, gsz = (size_t)G * 512;
    bf16_t* X = (bf16_t*)(p.ws() + WS_X);
    for (size_t i0 = gtid; i0 < (size_t)NTOK * DM / 8; i0 += 4 * gsz) {
        f32x4 a[4], b[4];
#pragma unroll
        for (int u = 0; u < 4; ++u) { const size_t i = i0 + u * gsz; const size_t e = (i < (size_t)NTOK * DM / 8 ? i : i0) * 8; const float* s = e < (size_t)NP * DM ? p.in(I_XP) + e : p.in(I_XS) + (e - (size_t)NP * DM);
            a[u] = *(const f32x4*)s; b[u] = *(const f32x4*)(s + 4); }
#pragma unroll
        for (int u = 0; u < 4; ++u) { const size_t i = i0 + u * gsz;
            if (i < (size_t)NTOK * DM / 8) { u32x4 w; w.x = cvt_pk_bf16(a[u][0], a[u][1]); w.y = cvt_pk_bf16(a[u][2], a[u][3]); w.z = cvt_pk_bf16(b[u][0], b[u][1]); w.w = cvt_pk_bf16(b[u][2], b[u][3]);
                *(u32x4*)(X + i * 8) = w; } } }
    float* rope = (float*)(p.ws() + WS_ROPE);
    for (size_t i = gtid; i < (size_t)2052 * 64; i += gsz) { const int pi = (int)(i >> 6), fi = (int)(i & 63);
        const double pos = pi < 2048 ? (double)pi : (double)(16384 + pi - 2048);
        const double ang = pos * INVF_TAB[fi];
        const double rr = ang - rint(ang * 0.15915494309189535) * 6.283185307179586;
        const float sn = __sinf((float)rr), cs = __cosf((float)rr);
        rope[(size_t)pi * 128 + fi] = cs; rope[(size_t)pi * 128 + 64 + fi] = sn; }
}

__device__ void phase_small(const DP& p, int l, LAS unsigned char* lds) {
    lds = launder_lds(lds);
    LAS float* wl = (LAS float*)lds;
    const int tid = my_tid(), lane = tid & 63, wave = tid >> 6, bid0 = my_bid();
    const float* win = p.in(I_WIN) + (size_t)l * 1024 * 9232;
    __syncthreads();
    {
#pragma unroll
        for (int i0 = 0; i0 < 32; i0 += 8) { float tmp[8];
#pragma unroll
            for (int i = 0; i < 8; ++i) { const int idx = tid + (i0 + i) * 512, k = idx >> 4, j = idx & 15; tmp[i] = win[(size_t)k * 9232 + (j < 8 ? 2048 + j : 6152 + (j - 8))]; }
#pragma unroll
            for (int i = 0; i < 8; ++i) { const int idx = tid + (i0 + i) * 512, k = idx >> 4, j = idx & 15; wl[j * 1024 + k] = tmp[i]; } } }
    __syncthreads();
    const bf16_t* X = (const bf16_t*)(p.ws() + WS_X); float* SM = (float*)(p.ws() + WS_SMALL);
    const int rstep = gridDim.x * 8; int r = bid0 * 8 + wave;
    u32x4 na = (u32x4){0u, 0u, 0u, 0u}, nb = na;
    if (r < NTOK) { na = *(const u32x4*)(X + (size_t)r * DM + lane * 16); nb = *(const u32x4*)(X + (size_t)r * DM + lane * 16 + 8); }
    for (; r < NTOK; r += rstep) {
        const u32x4 a = na, b = nb;
        if (r + rstep < NTOK) { na = *(const u32x4*)(X + (size_t)(r + rstep) * DM + lane * 16); nb = *(const u32x4*)(X + (size_t)(r + rstep) * DM + lane * 16 + 8); }
        float x[16] = {bflo(a.x), bfhi(a.x), bflo(a.y), bfhi(a.y), bflo(a.z), bfhi(a.z), bflo(a.w), bfhi(a.w), bflo(b.x), bfhi(b.x), bflo(b.y), bfhi(b.y), bflo(b.z), bfhi(b.z), bflo(b.w), bfhi(b.w)};
        float mine = 0.f;
#pragma unroll 1
        for (int j = 0; j < 16; ++j) { float s = 0.f;
#pragma unroll
            for (int q = 0; q < 4; ++q) { const f32x4 w = *(const LAS f32x4*)(wl + j * 1024 + lane * 16 + q * 4); s += x[q * 4] * w[0] + x[q * 4 + 1] * w[1] + x[q * 4 + 2] * w[2] + x[q * 4 + 3] * w[3]; }
#pragma unroll
            for (int o = 32; o >= 1; o >>= 1) s += __shfl_xor(s, o);
            if (lane == j) mine = s; }
        if (lane < 16) SM[(size_t)r * 16 + lane] = mine;
    }
    __syncthreads();
}

__device__ __forceinline__ void ln_finish(const f32x4 (&v)[4], int r, int lane, const float* __restrict__ g, const float* __restrict__ bta, bf16_t* __restrict__ O, float* __restrict__ yp, float* __restrict__ ys) {
    float s = 0.f;
#pragma unroll
    for (int i = 0; i < 4; ++i) s += (v[i][0] + v[i][1]) + (v[i][2] + v[i][3]);
#pragma unroll
    for (int o = 32; o >= 1; o >>= 1) s += __shfl_xor(s, o);
    const float mu = s * (1.0f / 1024.0f); float q = 0.f;
#pragma unroll
    for (int i = 0; i < 4; ++i) { const f32x4 d = v[i] - mu; q += (d[0] * d[0] + d[1] * d[1]) + (d[2] * d[2] + d[3] * d[3]); }
#pragma unroll
    for (int o = 32; o >= 1; o >>= 1) q += __shfl_xor(q, o);
    const float rstd = rsqrtf(q * (1.0f / 1024.0f) + 1e-5f);
    float* y = yp ? (r < NP ? yp + (size_t)r * DM : ys + (size_t)(r - NP) * DM) : nullptr;
#pragma unroll
    for (int i = 0; i < 4; ++i) { const int c = i * 256 + lane * 4; const f32x4 gg = *(const f32x4*)(g + c), bb = *(const f32x4*)(bta + c);
        const f32x4 o = (v[i] - mu) * rstd * gg + bb;
        u32x2 w; w.x = cvt_pk_bf16(o[0], o[1]); w.y = cvt_pk_bf16(o[2], o[3]); *(u32x2*)(O + (size_t)r * DM + c) = w;
        if (y) *(f32x4*)(y + c) = o; }
}
__device__ void phase_ln(const bf16_t* __restrict__ T, const float* __restrict__ TS, int npieces, const float* __restrict__ g, const float* __restrict__ bta, bf16_t* __restrict__ O, float* __restrict__ yp, float* __restrict__ ys) {
    const int tid0 = my_tid(), lane = tid0 & 63, wave = tid0 >> 6, bid0 = my_bid();
    const int stride = gridDim.x * 8;
    const int nbf = npieces == 0 ? NTOK : NP;
    int r0 = bid0 * 8 + wave;
    for (; r0 + 3 * stride < nbf; r0 += 4 * stride) {
        u32x2 hh[4][4];
#pragma unroll
        for (int k = 0; k < 4; ++k)
#pragma unroll
            for (int i = 0; i < 4; ++i) hh[k][i] = *(const u32x2*)(T + (size_t)(r0 + k * stride) * DM + i * 256 + lane * 4);
#pragma unroll
        for (int k = 0; k < 4; ++k) { f32x4 vv[4];
#pragma unroll
            for (int i = 0; i < 4; ++i) vv[i] = (f32x4){bflo(hh[k][i].x), bfhi(hh[k][i].x), bflo(hh[k][i].y), bfhi(hh[k][i].y)};
            ln_finish(vv, r0 + k * stride, lane, g, bta, O, yp, ys); }
    }
    for (; r0 < nbf; r0 += stride) {
        f32x4 vv[4];
#pragma unroll
        for (int i = 0; i < 4; ++i) { const u32x2 h = *(const u32x2*)(T + (size_t)r0 * DM + i * 256 + lane * 4); vv[i] = (f32x4){bflo(h.x), bfhi(h.x), bflo(h.y), bfhi(h.y)}; }
        ln_finish(vv, r0, lane, g, bta, O, yp, ys);
    }
    if (npieces > 0) for (int r = NP + bid0 * 8 + wave; r < NTOK; r += stride) {
        f32x4 v[4]; const float* tp = TS + (size_t)(r - NP) * DM;
#pragma unroll
        for (int i = 0; i < 4; ++i) v[i] = *(const f32x4*)(tp + i * 256 + lane * 4);
        for (int z0 = 1; z0 < npieces; z0 += 4) { f32x4 tmp[4][4];
#pragma unroll
            for (int zz = 0; zz < 4; ++zz) { const int z = (z0 + zz < npieces) ? z0 + zz : z0;
#pragma unroll
                for (int i = 0; i < 4; ++i) tmp[zz][i] = *(const f32x4*)(tp + (size_t)z * (512 * 1024) + i * 256 + lane * 4); }
#pragma unroll
            for (int zz = 0; zz < 4; ++zz) if (z0 + zz < npieces) {
#pragma unroll
                for (int i = 0; i < 4; ++i) v[i] += tmp[zz][i]; } }
        ln_finish(v, r, lane, g, bta, O, yp, ys);
    }
}
template <int MIX  >
__device__ void rec_item(const DP& p, int l, bool prompt, int b, int h, LAS unsigned char* lds) {
    lds = launder_lds(lds);
    int tid_l = threadIdx.x; asm volatile("" : "+v"(tid_l));
    const int tid = tid_l, lane = tid & 63, wave = tid >> 6;
    const int v = tid & 127, kg = tid >> 7, k0 = kg * 32;
    const int T = prompt ? SEQ : 4, NBt = prompt ? NB : NDB;
    const size_t row0 = prompt ? (size_t)b * SEQ : (size_t)NP + (size_t)b * 4;
    const int pi0 = prompt ? 0 : 2048;
    bf16_t* PROJ = (bf16_t*)(p.ws() + WS_PROJ); const float* SM = (const float*)(p.ws() + WS_SMALL); const float* rope = (const float*)(p.ws() + WS_ROPE);
    LAS float* vec = (LAS float*)lds;
    LAS float* red = vec + 768;
    LAS float* part = red + 1024;
    LAS float* partS = part + 16;
    LAS float* partN = partS + 4;
    const size_t sidx = ((size_t)(l * NBt + b) * 4 + h);
    float S[32];
    {
        const float* st_in = prompt ? nullptr : p.in(MIX == 0 ? I_SS : (MIX == 1 ? I_SR : I_SC)) + sidx * 16384;
#pragma unroll
        for (int i = 0; i < 32; ++i) S[i] = st_in ? st_in[(k0 + i) * 128 + v] : 0.f;
    }
    float nn = 0.f, mm = 0.f;
    if (MIX == 2 && !prompt) { if (tid < 128) nn = p.in(I_SN)[sidx * 128 + tid]; mm = p.in(I_SM)[sidx]; }
    const int which = tid >> 7, cc = tid & 127;
    const int colq = MIX * 2048 + h * 128, colg = colq + 1536;
    const int gcol = which * 512 + h * 128 + cc;
    float cw0 = 0.f, cw1 = 0.f, cw2 = 0.f, cw3 = 0.f, x0 = 0.f, x1 = 0.f, x2 = 0.f;
    if (MIX == 0 && tid < 384) {
        const float* cwp = p.in(I_CONVW) + (size_t)l * 4 * 1536 + gcol; cw0 = cwp[0]; cw1 = cwp[1536]; cw2 = cwp[2 * 1536]; cw3 = cwp[3 * 1536];
        if (!prompt) { const float* cb = p.in(I_SCONV) + (size_t)(l * NDB + b) * 3 * 1536 + gcol; x0 = cb[0]; x1 = cb[1536]; x2 = cb[2 * 1536]; }
    }
    float Aexp = 0.f, dtb = 0.f, normw = 1.f, gamma = 0.f, ib = 0.f, fb = 0.f;
    if (MIX == 0) { Aexp = __expf(p.in(I_ALOG)[l * 4 + h]); dtb = p.in(I_DTB)[l * 4 + h]; normw = p.in(I_DNW)[l * 128 + v]; }
    if (MIX == 1) gamma = 1.0f - exp2f(-5.0f - (float)h);
    if (MIX == 2) { ib = p.in(I_IB)[l * 4 + h]; fb = p.in(I_FB)[l * 4 + h]; normw = p.in(I_MLW)[l * 512 + h * 128 + v]; }
    bf16_t pa = 0, pb = 0, pg = 0; float s0 = 0.f, s1 = 0.f;
#define REC_PREFETCH(tt) do { const size_t r_ = row0 + (tt); const bf16_t* pr = PROJ + r_ * PW; \
        if (tid < 384) { \
            if (MIX == 0) pa = pr[gcol]; \
            else if (MIX == 1 && which < 2) { const int i_ = cc & 63; pa = pr[colq + which * 512 + i_]; pb = pr[colq + which * 512 + i_ + 64]; } \
            else pa = pr[colq + which * 512 + cc]; \
        } \
        if (tid < 128) pg = pr[colg + v]; \
        if (MIX == 0) { s0 = SM[r_ * 16 + h]; s1 = SM[r_ * 16 + 4 + h]; } \
        if (MIX == 2) { s0 = SM[r_ * 16 + 8 + h]; s1 = SM[r_ * 16 + 12 + h]; } } while (0)
    REC_PREFETCH(0);
    __syncthreads();
    for (int t = 0; t < T; ++t) {
        const int par = t & 1; const size_t r = row0 + t;
        const bf16_t ca = pa, cb = pb, cgate = pg; const float cs0 = s0, cs1 = s1;
        if (t + 1 < T) REC_PREFETCH(t + 1);
        if (tid < 384) {
            float val;
            if (MIX == 0) { const float xn = bf2f(ca); const float c = x0 * cw0 + x1 * cw1 + x2 * cw2 + xn * cw3; x0 = x1; x1 = x2; x2 = xn; val = siluf_(c);
                if (which < 2) { float q = val * val;
#pragma unroll
                    for (int o = 32; o >= 1; o >>= 1) q += __shfl_xor(q, o);
                    if (lane == 0) part[par * 8 + wave] = q; } }
            else if (MIX == 1 && which < 2) { const int i = cc & 63; const float xa = bf2f(ca), xb = bf2f(cb); const float cs = rope[(size_t)(pi0 + t) * 128 + i], sn = rope[(size_t)(pi0 + t) * 128 + 64 + i];
                val = cc < 64 ? xa * cs - xb * sn : xa * sn + xb * cs; if (which == 1) val *= DKS; }
            else { val = bf2f(ca); if (MIX != 0 && which == 1) val *= DKS; }
            vec[par * 384 + which * 128 + cc] = val;
        }
        __syncthreads();
        float a = 1.f, qs = 1.f, ks = 1.f, beta = 0.f, ipr = 1.f;
        if (MIX == 0) { beta = sigmoidf_(cs0); const float g = -Aexp * softplusf_(cs1 + dtb); a = __expf(g);
            qs = rsqrtf(part[par * 8 + 0] + part[par * 8 + 1] + 1e-6f) * DKS; ks = rsqrtf(part[par * 8 + 2] + part[par * 8 + 3] + 1e-6f); }
        if (MIX == 1) a = gamma;
        if (MIX == 2) { const float ip = cs0 + ib, fp = cs1 + fb; const float lf = logsigmoidf_(fp); const float mnew = fmaxf(lf + mm, ip); a = __expf(lf + mm - mnew); ipr = __expf(ip - mnew); mm = mnew; }
        const float vv = vec[par * 384 + 256 + v];
        float vnew;
        if (MIX == 0) { float pk = 0.f;
#pragma unroll
            for (int i = 0; i < 32; ++i) pk += vec[par * 384 + 128 + k0 + i] * S[i];
            red[kg * 128 + v] = pk * ks;
            __syncthreads();
            const float kS = (red[v] + red[128 + v]) + (red[256 + v] + red[384 + v]);
            vnew = beta * (vv - a * kS); }
        else if (MIX == 1) vnew = vv;
        else vnew = ipr * vv;
        float po = 0.f;
#pragma unroll
        for (int i = 0; i < 32; ++i) { S[i] = a * S[i] + (vec[par * 384 + 128 + k0 + i] * ks) * vnew; po += vec[par * 384 + k0 + i] * S[i]; }
        red[512 + kg * 128 + v] = po * qs;
        if (MIX == 2 && tid < 128) { nn = a * nn + ipr * vec[par * 384 + 128 + tid]; float qn = vec[par * 384 + tid] * nn;
#pragma unroll
            for (int o = 32; o >= 1; o >>= 1) qn += __shfl_xor(qn, o);
            if (lane == 0) partN[par * 2 + wave] = qn; }
        __syncthreads();
        float o = 0.f;
        if (tid < 128) { o = (red[512 + v] + red[512 + 128 + v]) + (red[512 + 256 + v] + red[512 + 384 + v]); float q = o * o;
#pragma unroll
            for (int of = 32; of >= 1; of >>= 1) q += __shfl_xor(q, of);
            if (lane == 0) partS[par * 2 + wave] = q; }
        __syncthreads();
        if (tid < 128) {
            const float ssq = partS[par * 2] + partS[par * 2 + 1]; const float gt = bf2f(cgate); float out;
            if (MIX == 2) { const float den = partN[par * 2] + partN[par * 2 + 1]; const float dd = fmaxf(fabsf(den), __expf(-mm)); const float hv = o / dd;
                out = hv * rsqrtf(ssq / (dd * dd) * (1.0f / 128.0f) + 1e-6f) * normw * sigmoidf_(gt); }
            else out = o * rsqrtf(ssq * (1.0f / 128.0f) + 1e-6f) * normw * siluf_(gt);
            PROJ[r * PW + colg + v] = f2bf(out);
        }
    }
    float* outp = p.out();
    {
        float* so = outp + (prompt ? (MIX == 0 ? O_PS : (MIX == 1 ? O_PR : O_PC)) : (MIX == 0 ? O_SS : (MIX == 1 ? O_SR : O_SC))) + sidx * 16384;
#pragma unroll
        for (int i = 0; i < 32; ++i) so[(k0 + i) * 128 + v] = S[i];
    }
    if (MIX == 0 && tid < 384) { float* co = outp + (prompt ? O_PCONV : O_SCONV) + (size_t)(l * NBt + b) * 3 * 1536 + gcol; co[0] = x0; co[1536] = x1; co[2 * 1536] = x2; }
    if (MIX == 2) { if (tid < 128) outp[(prompt ? O_PN : O_SN) + sidx * 128 + tid] = nn; if (tid == 0) outp[(prompt ? O_PM : O_SM) + sidx] = mm; }
    __syncthreads();
}
__device__ __forceinline__ bf16x8 ldfrag(const LAS bf16_t* base, int row, int ld, int k) { return *(const LAS bf16x8*)(base + row * ld + k); }
#define MFMA16(a, b, c) __builtin_amdgcn_mfma_f32_16x16x32_bf16((a), (b), (c), 0, 0, 0)

template <int MIX  >
__device__ void scan_item(const DP& p, int l, int b, int h, LAS unsigned char* lds) {
    lds = launder_lds(lds);
    const int tid = my_tid(), lane = tid & 63, wave = __builtin_amdgcn_readfirstlane(tid >> 6), l16 = lane & 15, quad = lane >> 4;
    bf16_t* PROJ = (bf16_t*)(p.ws() + WS_PROJ); const float* SM = (const float*)(p.ws() + WS_SMALL); const float* rope = (const float*)(p.ws() + WS_ROPE);
    LAS bf16_t* Qs = (LAS bf16_t*)(lds + 0); LAS bf16_t* Ks = (LAS bf16_t*)(lds + 17408); LAS bf16_t* KdT = (LAS bf16_t*)(lds + 34816);
    LAS bf16_t* VT = (LAS bf16_t*)(lds + 53248); LAS bf16_t* Ps = (LAS bf16_t*)(lds + 71680); LAS bf16_t* RT = (LAS bf16_t*)(lds + 80896);
    LAS float* red = (LAS float*)(lds + 115712); LAS float* GT = (LAS float*)(lds + 116224); LAS float* sdecs = (LAS float*)(lds + 118784);
    LAS float* nm = (LAS float*)(lds + 118800); LAS float* denl = (LAS float*)(lds + 119312);
    const int colq = MIX * 2048 + h * 128;
    const size_t row0 = (size_t)b * SEQ;
    const size_t sidx = (size_t)(l * NB + b) * 4 + h;
    __syncthreads();
    for (int i = tid; i < 128 * 136 / 2; i += 512) ((LAS unsigned*)RT)[i] = 0u;
    if (tid < 128) nm[tid] = 0.f;
    if (MIX == 1 && tid < 64) { const float lng = logf(1.0f - exp2f(-5.0f - (float)h));
#pragma unroll
        for (int par = 0; par < 2; ++par) { LAS float* G_ = GT + par * 320; G_[tid] = (float)tid * lng; G_[64 + tid] = -(float)tid * lng; G_[128 + tid] = __expf((float)(tid + 1) * lng); G_[192 + tid] = __expf((float)(63 - tid) * lng); G_[256 + tid] = 0.f; }
        if (tid == 0) { sdecs[0] = __expf(64.0f * lng); sdecs[1] = sdecs[0]; } }
    f32x4 Racc[8];
#pragma unroll
    for (int i = 0; i < 8; ++i) Racc[i] = (f32x4){0.f, 0.f, 0.f, 0.f};
    float mm = 0.f;
    const float ib = MIX == 2 ? p.in(I_IB)[l * 4 + h] : 0.f, fb = MIX == 2 ? p.in(I_FB)[l * 4 + h] : 0.f;
    const int lrow = tid & 63, cg = tid >> 6;
    u32x4 q1, q2, k1, k2, v1, v2; f32x4 rc0, rc1, rs0, rs1; float ipre = 0.f, fpre = 0.f; u32x2 gpre[4];
#define SC_LOAD(n_) do { const bf16_t* pr = PROJ + (row0 + (size_t)(n_) * 64 + lrow) * PW + colq; \
        q1 = *(const u32x4*)(pr + cg * 8); q2 = *(const u32x4*)(pr + 64 + cg * 8); k1 = *(const u32x4*)(pr + 512 + cg * 8); k2 = *(const u32x4*)(pr + 512 + 64 + cg * 8); \
        v1 = *(const u32x4*)(pr + 1024 + cg * 16); v2 = *(const u32x4*)(pr + 1024 + cg * 16 + 8); \
        if (MIX == 1) { const float* rp = rope + (size_t)((n_) * 64 + lrow) * 128 + cg * 8; rc0 = *(const f32x4*)rp; rc1 = *(const f32x4*)(rp + 4); rs0 = *(const f32x4*)(rp + 64); rs1 = *(const f32x4*)(rp + 68); } \
        if (MIX == 2 && wave == 0) { const size_t r_ = row0 + (size_t)(n_) * 64 + lane; ipre = SM[r_ * 16 + 8 + h]; fpre = SM[r_ * 16 + 12 + h]; } } while (0)
#define SC_GATES(n_) do { const float ip = ipre + ib, fp = fpre + fb; \
        float F = logsigmoidf_(fp); \
        _Pragma("unroll") for (int d = 1; d < 64; d <<= 1) { const float y = __shfl_up(F, d); if (lane >= d) F += y; } \
        const float a_ = ip - F; float cm = a_; \
        _Pragma("unroll") for (int d = 1; d < 64; d <<= 1) { const float y = __shfl_up(cm, d); if (lane >= d) cm = fmaxf(cm, y); } \
        const float mt = fmaxf(mm + F, F + cm); const float wst = __expf(mm + F - mt); \
        const float mnew = __shfl(mt, 63), Fl = __shfl(F, 63); \
        LAS float* G_ = GT + ((n_) & 1) * 320; G_[lane] = F - mt; G_[64 + lane] = a_; G_[128 + lane] = wst; G_[192 + lane] = __expf(a_ + Fl - mnew); G_[256 + lane] = __expf(-mt); \
        if (lane == 0) sdecs[(n_) & 1] = __expf(mm + Fl - mnew); mm = mnew; } while (0)
#define SC_STORE(n_) do { const int t_ = lrow; \
        float qa[8], qb[8], ka[8], kb[8]; \
        { const unsigned qw1[4] = {q1.x, q1.y, q1.z, q1.w}, qw2[4] = {q2.x, q2.y, q2.z, q2.w}, kw1[4] = {k1.x, k1.y, k1.z, k1.w}, kw2[4] = {k2.x, k2.y, k2.z, k2.w}; \
          _Pragma("unroll") for (int e = 0; e < 4; ++e) { qa[2 * e] = bflo(qw1[e]); qa[2 * e + 1] = bfhi(qw1[e]); qb[2 * e] = bflo(qw2[e]); qb[2 * e + 1] = bfhi(qw2[e]); \
              ka[2 * e] = bflo(kw1[e]); ka[2 * e + 1] = bfhi(kw1[e]); kb[2 * e] = bflo(kw2[e]); kb[2 * e + 1] = bfhi(kw2[e]); } } \
        float kdec; \
        if (MIX == 1) { const f32x4 c0 = rc0, c1 = rc1, s0 = rs0, s1 = rs1; \
            const float cs[8] = {c0[0], c0[1], c0[2], c0[3], c1[0], c1[1], c1[2], c1[3]}, sn[8] = {s0[0], s0[1], s0[2], s0[3], s1[0], s1[1], s1[2], s1[3]}; \
            _Pragma("unroll") for (int e = 0; e < 8; ++e) { const float x1 = qa[e], x2 = qb[e]; qa[e] = x1 * cs[e] - x2 * sn[e]; qb[e] = x1 * sn[e] + x2 * cs[e]; \
                const float y1 = ka[e], y2 = kb[e]; ka[e] = y1 * cs[e] - y2 * sn[e]; kb[e] = y1 * sn[e] + y2 * cs[e]; } \
            } \
        kdec = GT[((n_) & 1) * 320 + 192 + t_]; \
        _Pragma("unroll") for (int e = 0; e < 8; ++e) { ka[e] *= DKS; kb[e] *= DKS; } \
        { u32x4 w; w.x = cvt_pk_bf16(qa[0], qa[1]); w.y = cvt_pk_bf16(qa[2], qa[3]); w.z = cvt_pk_bf16(qa[4], qa[5]); w.w = cvt_pk_bf16(qa[6], qa[7]); *(LAS u32x4*)(Qs + t_ * 136 + cg * 8) = w; \
          w.x = cvt_pk_bf16(qb[0], qb[1]); w.y = cvt_pk_bf16(qb[2], qb[3]); w.z = cvt_pk_bf16(qb[4], qb[5]); w.w = cvt_pk_bf16(qb[6], qb[7]); *(LAS u32x4*)(Qs + t_ * 136 + 64 + cg * 8) = w; \
          w.x = cvt_pk_bf16(ka[0], ka[1]); w.y = cvt_pk_bf16(ka[2], ka[3]); w.z = cvt_pk_bf16(ka[4], ka[5]); w.w = cvt_pk_bf16(ka[6], ka[7]); *(LAS u32x4*)(Ks + t_ * 136 + cg * 8) = w; \
          w.x = cvt_pk_bf16(kb[0], kb[1]); w.y = cvt_pk_bf16(kb[2], kb[3]); w.z = cvt_pk_bf16(kb[4], kb[5]); w.w = cvt_pk_bf16(kb[6], kb[7]); *(LAS u32x4*)(Ks + t_ * 136 + 64 + cg * 8) = w; } \
        _Pragma("unroll") for (int e = 0; e < 8; ++e) { KdT[(cg * 8 + e) * 72 + t_] = f2bf(ka[e] * kdec); KdT[(64 + cg * 8 + e) * 72 + t_] = f2bf(kb[e] * kdec); } \
        { const unsigned vw[8] = {v1.x, v1.y, v1.z, v1.w, v2.x, v2.y, v2.z, v2.w}; \
          _Pragma("unroll") for (int e = 0; e < 8; ++e) { VT[(cg * 16 + 2 * e) * 72 + t_] = (bf16_t)(vw[e] & 0xffffu); VT[(cg * 16 + 2 * e + 1) * 72 + t_] = (bf16_t)(vw[e] >> 16); } } } while (0)

    SC_LOAD(0);
    if (MIX == 2 && wave == 0) SC_GATES(0);
    __syncthreads();
    SC_STORE(0);
    const int tm = wave >> 1, tnb = (wave & 1) * 2, tnb4 = (wave & 1) * 4;
    f32x4 nwv[4];
#pragma unroll
    for (int i = 0; i < 4; ++i) nwv[i] = MIX == 2 ? *(const f32x4*)(p.in(I_MLW) + l * 512 + h * 128 + 16 * (tnb4 + i) + 4 * quad) : (f32x4){1.f, 1.f, 1.f, 1.f};
    const int t = 16 * tm + l16;
    for (int n = 0; n < 32; ++n) {
        __syncthreads();
        if (n + 1 < 32) SC_LOAD(n + 1);
        { const bf16_t* gp_ = PROJ + (row0 + (size_t)n * 64 + t) * PW + colq + 1536;
#pragma unroll
          for (int i = 0; i < 4; ++i) gpre[i] = *(const u32x2*)(gp_ + 16 * (tnb4 + i) + 4 * quad); }
        const LAS float* G = GT + (n & 1) * 320;
        {
            f32x4 pacc[2] = {(f32x4){0.f, 0.f, 0.f, 0.f}, (f32x4){0.f, 0.f, 0.f, 0.f}};
#pragma unroll
            for (int kk = 0; kk < 4; ++kk) { const bf16x8 a = ldfrag(Qs, t, 136, kk * 32 + quad * 8);
#pragma unroll
                for (int i = 0; i < 2; ++i) { const bf16x8 bq = ldfrag(Ks, 16 * (tnb + i) + l16, 136, kk * 32 + quad * 8); pacc[i] = MFMA16(bq, a, pacc[i]); } }
            const float gt_ = G[t];
#pragma unroll
            for (int i = 0; i < 2; ++i) { const int s0 = 16 * (tnb + i) + 4 * quad; float w[4]; const f32x4 ga = *(const LAS f32x4*)(G + 64 + s0);
#pragma unroll
                for (int j = 0; j < 4; ++j) { const int s = s0 + j; float f;
                    f = __expf(gt_ + ga[j]);
                    w[j] = s <= t ? pacc[i][j] * f : 0.f; }
                u32x2 o; o.x = cvt_pk_bf16(w[0], w[1]); o.y = cvt_pk_bf16(w[2], w[3]); *(LAS u32x2*)(Ps + t * 72 + s0) = o; }
        }
        __syncthreads();
        f32x4 o2[4];
        {
            f32x4 o1[4];
#pragma unroll
            for (int i = 0; i < 4; ++i) { o1[i] = (f32x4){0.f, 0.f, 0.f, 0.f}; o2[i] = (f32x4){0.f, 0.f, 0.f, 0.f}; }
#pragma unroll
            for (int kk = 0; kk < 4; ++kk) { const bf16x8 a = ldfrag(Qs, t, 136, kk * 32 + quad * 8);
#pragma unroll
                for (int i = 0; i < 4; ++i) { const bf16x8 bq = ldfrag(RT, 16 * (tnb4 + i) + l16, 136, kk * 32 + quad * 8); o1[i] = MFMA16(bq, a, o1[i]); } }
#pragma unroll
            for (int kk = 0; kk < 2; ++kk) { const bf16x8 a = ldfrag(Ps, t, 72, kk * 32 + quad * 8);
#pragma unroll
                for (int i = 0; i < 4; ++i) { const bf16x8 bq = ldfrag(VT, 16 * (tnb4 + i) + l16, 72, kk * 32 + quad * 8); o2[i] = MFMA16(bq, a, o2[i]); } }
            const float qd = G[128 + t];
            float ssq = 0.f;
#pragma unroll
            for (int i = 0; i < 4; ++i) { o2[i] = o1[i] * qd + o2[i]; ssq += (o2[i][0] * o2[i][0] + o2[i][1] * o2[i][1]) + (o2[i][2] * o2[i][2] + o2[i][3] * o2[i][3]); }
            ssq += __shfl_xor(ssq, 16); ssq += __shfl_xor(ssq, 32);
            if (quad == 0) red[t * 2 + (wave & 1)] = ssq;
        }
        float nnew = 0.f;
        if (MIX == 2) {
            { const int tp = tid >> 3, part = tid & 7; float qn = 0.f, ds = 0.f;
              const u32x4 qa_ = *(const LAS u32x4*)(Qs + tp * 136 + part * 16), qb_ = *(const LAS u32x4*)(Qs + tp * 136 + part * 16 + 8), pp_ = *(const LAS u32x4*)(Ps + tp * 72 + part * 8);
              const f32x4 n0 = *(const LAS f32x4*)(nm + part * 16), n1 = *(const LAS f32x4*)(nm + part * 16 + 4), n2 = *(const LAS f32x4*)(nm + part * 16 + 8), n3 = *(const LAS f32x4*)(nm + part * 16 + 12);
              qn = (bflo(qa_.x) * n0[0] + bfhi(qa_.x) * n0[1]) + (bflo(qa_.y) * n0[2] + bfhi(qa_.y) * n0[3]) + (bflo(qa_.z) * n1[0] + bfhi(qa_.z) * n1[1]) + (bflo(qa_.w) * n1[2] + bfhi(qa_.w) * n1[3])
                 + (bflo(qb_.x) * n2[0] + bfhi(qb_.x) * n2[1]) + (bflo(qb_.y) * n2[2] + bfhi(qb_.y) * n2[3]) + (bflo(qb_.z) * n3[0] + bfhi(qb_.z) * n3[1]) + (bflo(qb_.w) * n3[2] + bfhi(qb_.w) * n3[3]);
              ds = (bflo(pp_.x) + bfhi(pp_.x)) + (bflo(pp_.y) + bfhi(pp_.y)) + (bflo(pp_.z) + bfhi(pp_.z)) + (bflo(pp_.w) + bfhi(pp_.w));
              qn += __shfl_xor(qn, 1); qn += __shfl_xor(qn, 2); qn += __shfl_xor(qn, 4); ds += __shfl_xor(ds, 1); ds += __shfl_xor(ds, 2); ds += __shfl_xor(ds, 4);
              if (part == 0) denl[tp] = G[128 + tp] * qn + ds; }
            { const int kp = tid >> 2, pp = tid & 3;
              const u32x4 ka_ = *(const LAS u32x4*)(KdT + kp * 72 + pp * 16), kb_ = *(const LAS u32x4*)(KdT + kp * 72 + pp * 16 + 8);
              float sm = ((bflo(ka_.x) + bfhi(ka_.x)) + (bflo(ka_.y) + bfhi(ka_.y))) + ((bflo(ka_.z) + bfhi(ka_.z)) + (bflo(ka_.w) + bfhi(ka_.w)))
                       + ((bflo(kb_.x) + bfhi(kb_.x)) + (bflo(kb_.y) + bfhi(kb_.y))) + ((bflo(kb_.z) + bfhi(kb_.z)) + (bflo(kb_.w) + bfhi(kb_.w)));
              sm += __shfl_xor(sm, 1); sm += __shfl_xor(sm, 2);
              nnew = sdecs[n & 1] * nm[kp] + sm; }
        }
        {
            const float cdec = sdecs[n & 1];
#pragma unroll
            for (int tn = 0; tn < 8; ++tn) Racc[tn] = Racc[tn] * cdec;
#pragma unroll
            for (int kk = 0; kk < 2; ++kk) { const bf16x8 a = ldfrag(KdT, 16 * wave + l16, 72, kk * 32 + quad * 8);
#pragma unroll
                for (int tn = 0; tn < 8; ++tn) { const bf16x8 bq = ldfrag(VT, 16 * tn + l16, 72, kk * 32 + quad * 8); Racc[tn] = MFMA16(a, bq, Racc[tn]); } }
        }
        if (MIX == 2 && wave == 0 && n + 1 < 32) SC_GATES(n + 1);
        __syncthreads();
#pragma unroll
        for (int tn = 0; tn < 8; ++tn) { u32x2 o; o.x = cvt_pk_bf16(Racc[tn][0], Racc[tn][1]); o.y = cvt_pk_bf16(Racc[tn][2], Racc[tn][3]); *(LAS u32x2*)(RT + (16 * tn + l16) * 136 + 16 * wave + 4 * quad) = o; }
        if (MIX == 2 && (tid & 3) == 0) nm[tid >> 2] = nnew;
        {
            const float ssqt = red[t * 2] + red[t * 2 + 1]; float rs;
            if (MIX == 1) rs = rsqrtf(ssqt * (1.0f / 128.0f) + 1e-6f);
            else { const float dd = fmaxf(fabsf(denl[t]), G[256 + t]); const float inv = 1.0f / dd; rs = inv * rsqrtf(ssqt * inv * inv * (1.0f / 128.0f) + 1e-6f); }
            bf16_t* gp = PROJ + (row0 + (size_t)n * 64 + t) * PW + colq + 1536;
#pragma unroll
            for (int i = 0; i < 4; ++i) { const int c0 = 16 * (tnb4 + i) + 4 * quad; const u32x2 gv = gpre[i]; float g4[4] = {bflo(gv.x), bfhi(gv.x), bflo(gv.y), bfhi(gv.y)}, r4[4];
                if (MIX == 1) {
#pragma unroll
                    for (int j = 0; j < 4; ++j) r4[j] = o2[i][j] * rs * siluf_(g4[j]); }
                else { const f32x4 nw = nwv[i];
#pragma unroll
                    for (int j = 0; j < 4; ++j) r4[j] = o2[i][j] * rs * nw[j] * sigmoidf_(g4[j]); }
                u32x2 ov; ov.x = cvt_pk_bf16(r4[0], r4[1]); ov.y = cvt_pk_bf16(r4[2], r4[3]); *(u32x2*)(gp + c0) = ov; }
        }
        if (n + 1 < 32) SC_STORE(n + 1);
    }
    {
        float* so = p.out() + (MIX == 1 ? O_PR : O_PC) + sidx * 16384;
#pragma unroll
        for (int tn = 0; tn < 8; ++tn)
#pragma unroll
            for (int j = 0; j < 4; ++j) so[(16 * wave + 4 * quad + j) * 128 + 16 * tn + l16] = Racc[tn][j];
    }
    __syncthreads();
    if (MIX == 2) { if (tid < 128) p.out()[O_PN + sidx * 128 + tid] = nm[tid]; if (tid == 0) p.out()[O_PM + sidx] = mm; }
    __syncthreads();
#undef SC_LOAD
#undef SC_GATES
#undef SC_STORE
}
__device__ void dn_prep_item(const DP& p, int l, int b, int n, int h, LAS unsigned char* lds) {
    lds = launder_lds(lds);
    const int tid = my_tid(), lane = tid & 63, wave = __builtin_amdgcn_readfirstlane(tid >> 6), l16 = lane & 15, quad = lane >> 4;
    const bf16_t* PROJ = (const bf16_t*)(p.ws() + WS_PROJ); const float* SM = (const float*)(p.ws() + WS_SMALL);
    LAS bf16_t* Kn = (LAS bf16_t*)(lds + 0); LAS bf16_t* Qn = (LAS bf16_t*)(lds + 17408); LAS float* MT = (LAS float*)(lds + 34816);
    LAS float* Vf = (LAS float*)(lds + 52224); LAS float* Kf = (LAS float*)(lds + 84992);
    LAS float* gcs = (LAS float*)(lds + 117760); LAS float* betas = gcs + 64; LAS float* egs = gcs + 128;
    LAS bf16_t* MB = (LAS bf16_t*)(lds + 118528);
    LAS bf16_t* XT = (LAS bf16_t*)(lds + 0);
    const size_t row0 = (size_t)b * SEQ + (size_t)n * 64;
    const int ci = (b * 4 + h) * 32 + n;
    unsigned char* aux = p.ws() + WS_AUX;
    __syncthreads();
    LAS float* cwl = MT;
    if (tid < 384) { const int wh_ = tid >> 7, cc_ = tid & 127; const float* cwp = p.in(I_CONVW) + (size_t)l * 4 * 1536 + wh_ * 512 + h * 128 + cc_;
#pragma unroll
        for (int j = 0; j < 4; ++j) cwl[(wh_ * 4 + j) * 128 + cc_] = cwp[j * 1536]; }
    if (wave == 0) {
        const size_t r = row0 + lane; const float beta = sigmoidf_(SM[r * 16 + h]);
        float gc = -__expf(p.in(I_ALOG)[l * 4 + h]) * softplusf_(SM[r * 16 + 4 + h] + p.in(I_DTB)[l * 4 + h]);
#pragma unroll
        for (int d = 1; d < 64; d <<= 1) { const float y = __shfl_up(gc, d); if (lane >= d) gc += y; }
        gcs[lane] = gc; betas[lane] = beta; egs[lane] = __expf(gc);
        if (lane == 63) ((float*)(aux + AUX_EG))[ci] = __expf(gc);
    }
    __syncthreads();
    const int t = tid >> 3, cg = tid & 7;
    float qv[16];
#pragma unroll
    for (int which = 0; which < 3; ++which) {
        const int gcol = which * 512 + h * 128 + cg * 16;
        float acc[16], xs[16];
#pragma unroll
        for (int e = 0; e < 16; ++e) { acc[e] = 0.f; xs[e] = 0.f; }
        u32x4 xa[4], xb[4];
#pragma unroll
        for (int j = 0; j < 4; ++j) { const int tok = n * 64 + t + j - 3; const int tokc = tok < 0 ? 0 : tok;
            const bf16_t* xp = PROJ + ((size_t)b * SEQ + tokc) * PW + gcol; xa[j] = *(const u32x4*)xp; xb[j] = *(const u32x4*)(xp + 8); }
#pragma unroll
        for (int j = 0; j < 4; ++j) { const int tok = n * 64 + t + j - 3; const float msk = tok >= 0 ? 1.0f : 0.0f;
            const LAS float* wp = cwl + (which * 4 + j) * 128 + cg * 16;
            const f32x4 w0 = *(const LAS f32x4*)wp, w1 = *(const LAS f32x4*)(wp + 4), w2 = *(const LAS f32x4*)(wp + 8), w3 = *(const LAS f32x4*)(wp + 12);
            const float xf[16] = {bflo(xa[j].x), bfhi(xa[j].x), bflo(xa[j].y), bfhi(xa[j].y), bflo(xa[j].z), bfhi(xa[j].z), bflo(xa[j].w), bfhi(xa[j].w), bflo(xb[j].x), bfhi(xb[j].x), bflo(xb[j].y), bfhi(xb[j].y), bflo(xb[j].z), bfhi(xb[j].z), bflo(xb[j].w), bfhi(xb[j].w)};
            const float wf[16] = {w0[0], w0[1], w0[2], w0[3], w1[0], w1[1], w1[2], w1[3], w2[0], w2[1], w2[2], w2[3], w3[0], w3[1], w3[2], w3[3]};
#pragma unroll
            for (int e = 0; e < 16; ++e) { acc[e] += xf[e] * (wf[e] * msk); if (j == 3) xs[e] = xf[e]; }
        }
        if (n == 31 && t >= 61) { float* co = p.out() + O_PCONV + ((size_t)(l * NB + b) * 3 + (t - 61)) * 1536 + gcol;
#pragma unroll
            for (int e = 0; e < 16; ++e) co[e] = xs[e]; }
        float ssq = 0.f;
#pragma unroll
        for (int e = 0; e < 16; ++e) { acc[e] = siluf_(acc[e]); ssq += acc[e] * acc[e]; }
        if (which < 2) { ssq += __shfl_xor(ssq, 1); ssq += __shfl_xor(ssq, 2); ssq += __shfl_xor(ssq, 4);
            const float sc = rsqrtf(ssq + 1e-6f) * (which == 0 ? DKS : 1.0f);
#pragma unroll
            for (int e = 0; e < 16; ++e) acc[e] *= sc; }
        if (which == 0) {
#pragma unroll
            for (int e = 0; e < 16; ++e) qv[e] = acc[e];
            u32x4 w; w.x = cvt_pk_bf16(acc[0], acc[1]); w.y = cvt_pk_bf16(acc[2], acc[3]); w.z = cvt_pk_bf16(acc[4], acc[5]); w.w = cvt_pk_bf16(acc[6], acc[7]); *(LAS u32x4*)(Qn + t * 136 + cg * 16) = w;
            w.x = cvt_pk_bf16(acc[8], acc[9]); w.y = cvt_pk_bf16(acc[10], acc[11]); w.z = cvt_pk_bf16(acc[12], acc[13]); w.w = cvt_pk_bf16(acc[14], acc[15]); *(LAS u32x4*)(Qn + t * 136 + cg * 16 + 8) = w;
        } else if (which == 1) {
            u32x4 w; w.x = cvt_pk_bf16(acc[0], acc[1]); w.y = cvt_pk_bf16(acc[2], acc[3]); w.z = cvt_pk_bf16(acc[4], acc[5]); w.w = cvt_pk_bf16(acc[6], acc[7]); *(LAS u32x4*)(Kn + t * 136 + cg * 16) = w;
            w.x = cvt_pk_bf16(acc[8], acc[9]); w.y = cvt_pk_bf16(acc[10], acc[11]); w.z = cvt_pk_bf16(acc[12], acc[13]); w.w = cvt_pk_bf16(acc[14], acc[15]); *(LAS u32x4*)(Kn + t * 136 + cg * 16 + 8) = w;
#pragma unroll
            for (int q4 = 0; q4 < 4; ++q4) *(LAS f32x4*)(Kf + t * 128 + cg * 16 + q4 * 4) = (f32x4){acc[q4 * 4], acc[q4 * 4 + 1], acc[q4 * 4 + 2], acc[q4 * 4 + 3]};
        } else {
#pragma unroll
            for (int q4 = 0; q4 < 4; ++q4) *(LAS f32x4*)(Vf + t * 128 + cg * 16 + q4 * 4) = (f32x4){acc[q4 * 4], acc[q4 * 4 + 1], acc[q4 * 4 + 2], acc[q4 * 4 + 3]};
        }
    }
    __syncthreads();
    { const float eg = egs[t]; bf16_t* o = (bf16_t*)(aux + AUX_QG) + (size_t)ci * 8192 + t * 128 + cg * 16;
      u32x4 w; w.x = cvt_pk_bf16(qv[0] * eg, qv[1] * eg); w.y = cvt_pk_bf16(qv[2] * eg, qv[3] * eg); w.z = cvt_pk_bf16(qv[4] * eg, qv[5] * eg); w.w = cvt_pk_bf16(qv[6] * eg, qv[7] * eg); *(u32x4*)o = w;
      w.x = cvt_pk_bf16(qv[8] * eg, qv[9] * eg); w.y = cvt_pk_bf16(qv[10] * eg, qv[11] * eg); w.z = cvt_pk_bf16(qv[12] * eg, qv[13] * eg); w.w = cvt_pk_bf16(qv[14] * eg, qv[15] * eg); *(u32x4*)(o + 8) = w; }
    { const int k = tid >> 2, sq = tid & 3; const float gl = gcs[63]; float vals[16];
#pragma unroll
      for (int e = 0; e < 16; ++e) { const int s = sq * 16 + e; vals[e] = Kf[s * 128 + k] * __expf(gl - gcs[s]); }
      bf16_t* o = (bf16_t*)(aux + AUX_KDT) + (size_t)ci * 8192 + k * 64 + sq * 16;
      u32x4 w; w.x = cvt_pk_bf16(vals[0], vals[1]); w.y = cvt_pk_bf16(vals[2], vals[3]); w.z = cvt_pk_bf16(vals[4], vals[5]); w.w = cvt_pk_bf16(vals[6], vals[7]); *(u32x4*)o = w;
      w.x = cvt_pk_bf16(vals[8], vals[9]); w.y = cvt_pk_bf16(vals[10], vals[11]); w.z = cvt_pk_bf16(vals[12], vals[13]); w.w = cvt_pk_bf16(vals[14], vals[15]); *(u32x4*)(o + 8) = w; }
    {
        const int tm = wave >> 1, tnb = (wave & 1) * 2;
        f32x4 kk[2] = {(f32x4){0.f, 0.f, 0.f, 0.f}, (f32x4){0.f, 0.f, 0.f, 0.f}}, qk[2] = {(f32x4){0.f, 0.f, 0.f, 0.f}, (f32x4){0.f, 0.f, 0.f, 0.f}};
#pragma unroll
        for (int kx = 0; kx < 4; ++kx) { const bf16x8 ak = ldfrag(Kn, 16 * tm + l16, 136, kx * 32 + quad * 8), aq = ldfrag(Qn, 16 * tm + l16, 136, kx * 32 + quad * 8);
#pragma unroll
            for (int i = 0; i < 2; ++i) { const bf16x8 bk = ldfrag(Kn, 16 * (tnb + i) + l16, 136, kx * 32 + quad * 8); kk[i] = MFMA16(ak, bk, kk[i]); qk[i] = MFMA16(bk, aq, qk[i]); } }
#pragma unroll
        for (int i = 0; i < 2; ++i) {
            { const int s = 16 * (tnb + i) + l16; const float gs = gcs[s]; f32x4 m;
#pragma unroll
              for (int j = 0; j < 4; ++j) { const int tt = 16 * tm + 4 * quad + j; m[j] = tt > s ? betas[tt] * kk[i][j] * __expf(gcs[tt] - gs) : 0.f; }
              *(LAS f32x4*)(MT + s * 68 + 16 * tm + 4 * quad) = m;
#pragma unroll
              for (int j = 0; j < 4; ++j) MB[(16 * tm + 4 * quad + j) * 72 + s] = f2bf(m[j]); }
            { const int tt = 16 * tm + l16, s0 = 16 * (tnb + i) + 4 * quad; const float gt_ = gcs[tt]; float w4[4];
#pragma unroll
              for (int j = 0; j < 4; ++j) { const int s = s0 + j; w4[j] = s <= tt ? qk[i][j] * __expf(gt_ - gcs[s]) : 0.f; }
              u32x2 o; o.x = cvt_pk_bf16(w4[0], w4[1]); o.y = cvt_pk_bf16(w4[2], w4[3]); *(u32x2*)((bf16_t*)(aux + AUX_QK) + (size_t)ci * 4096 + tt * 64 + s0) = o; }
        }
    }
    __syncthreads();
    { const float bt = betas[t], be = bt * egs[t];
#pragma unroll
      for (int q4 = 0; q4 < 4; ++q4) { LAS f32x4* vp = (LAS f32x4*)(Vf + t * 128 + cg * 16 + q4 * 4); *vp = *vp * bt; LAS f32x4* kp = (LAS f32x4*)(Kf + t * 128 + cg * 16 + q4 * 4); *kp = *kp * be; } }
    __syncthreads();
#pragma unroll
    for (int ib = 0; ib < 4; ++ib) {
        if (tid < 256) {
            const int c = tid; const LAS float* R = c < 128 ? Vf + c : Kf + (c - 128); float r[16];
#pragma unroll
            for (int j = 0; j < 16; ++j) r[j] = R[(16 * ib + j) * 128];
#pragma unroll
            for (int s = 0; s < 15; ++s) {
#pragma unroll
                for (int v4 = (s + 1) >> 2; v4 < 4; ++v4) { const f32x4 mv = *(const LAS f32x4*)(MT + (16 * ib + s) * 68 + 16 * ib + 4 * v4);
#pragma unroll
                    for (int e = 0; e < 4; ++e) { const int tt = 4 * v4 + e; if (tt > s) r[tt] -= mv[e] * r[s]; } }
            }
            u32x4 w0, w1; w0.x = cvt_pk_bf16(r[0], r[1]); w0.y = cvt_pk_bf16(r[2], r[3]); w0.z = cvt_pk_bf16(r[4], r[5]); w0.w = cvt_pk_bf16(r[6], r[7]);
            w1.x = cvt_pk_bf16(r[8], r[9]); w1.y = cvt_pk_bf16(r[10], r[11]); w1.z = cvt_pk_bf16(r[12], r[13]); w1.w = cvt_pk_bf16(r[14], r[15]);
            if (c < 128) { bf16_t* o = (bf16_t*)(aux + AUX_UT) + (size_t)ci * 8192 + c * 64 + 16 * ib; *(u32x4*)o = w0; *(u32x4*)(o + 8) = w1; }
            else { bf16_t* o = (bf16_t*)(aux + AUX_W) + (size_t)ci * 8192 + (size_t)(16 * ib) * 128 + (c - 128);
#pragma unroll
                for (int j = 0; j < 16; ++j) o[j * 128] = f2bf(r[j]); }
            if (ib < 3) { *(LAS u32x4*)(XT + c * 64 + 16 * ib) = w0; *(LAS u32x4*)(XT + c * 64 + 16 * ib + 8) = w1; }
        }
        if (ib < 3) {
            __syncthreads();
#pragma unroll
            for (int q = 0; q < 2 * (3 - ib); ++q) { const int T = wave + 8 * q, tr = T >> 4, tc = T & 15;
                bf16x8 a = (bf16x8){0, 0, 0, 0, 0, 0, 0, 0}, bq = (bf16x8){0, 0, 0, 0, 0, 0, 0, 0};
                if (quad < 2) { a = ldfrag(MB, 16 * (ib + 1 + tr) + l16, 72, 16 * ib + quad * 8); bq = *(const LAS bf16x8*)(XT + (16 * tc + l16) * 64 + 16 * ib + quad * 8); }
                const f32x4 acc = MFMA16(a, bq, ((f32x4){0.f, 0.f, 0.f, 0.f}));
                LAS float* R = tc < 8 ? Vf + 16 * tc + l16 : Kf + 16 * (tc - 8) + l16;
#pragma unroll
                for (int j = 0; j < 4; ++j) R[(16 * (ib + 1 + tr) + 4 * quad + j) * 128] -= acc[j]; }
            __syncthreads();
        }
    }
}

__device__ void dn_scan_item(const DP& p, int l, int b, int h, LAS unsigned char* lds) {
    lds = launder_lds(lds);
    const int tid = my_tid(), lane = tid & 63, wave = __builtin_amdgcn_readfirstlane(tid >> 6), l16 = lane & 15, quad = lane >> 4;
    bf16_t* PROJ = (bf16_t*)(p.ws() + WS_PROJ); const unsigned char* aux = p.ws() + WS_AUX;
    LAS bf16_t* Ws = (LAS bf16_t*)(lds + 0); LAS bf16_t* QGs = (LAS bf16_t*)(lds + 17408); LAS bf16_t* QKs = (LAS bf16_t*)(lds + 34816);
    LAS bf16_t* KDTs = (LAS bf16_t*)(lds + 44032); LAS bf16_t* VnT = (LAS bf16_t*)(lds + 62464); LAS bf16_t* ST = (LAS bf16_t*)(lds + 80896);
    LAS float* red = (LAS float*)(lds + 115712);
    const size_t row0 = (size_t)b * SEQ; const size_t sidx = (size_t)(l * NB + b) * 4 + h; const int ci0 = (b * 4 + h) * 32;
    __syncthreads();
    for (int i = tid; i < 128 * 136 / 2; i += 512) ((LAS unsigned*)ST)[i] = 0u;
    f32x4 Sacc[8];
#pragma unroll
    for (int i = 0; i < 8; ++i) Sacc[i] = (f32x4){0.f, 0.f, 0.f, 0.f};
    const int tm = wave >> 1, tnb4 = (wave & 1) * 4;
    f32x4 nwv[4];
#pragma unroll
    for (int i = 0; i < 4; ++i) nwv[i] = *(const f32x4*)(p.in(I_DNW) + l * 128 + 16 * (tnb4 + i) + 4 * quad);
    u32x4 w1, w2, g1, g2, k1, k2, qk1; u32x2 ut[4]; float eg = 1.f;
#define DN_LOAD(n_) do { const size_t ci_ = (size_t)(ci0 + (n_)); \
        const bf16_t* wg = (const bf16_t*)(aux + AUX_W) + ci_ * 8192; w1 = *(const u32x4*)(wg + tid * 8); w2 = *(const u32x4*)(wg + (tid + 512) * 8); \
        const bf16_t* qg = (const bf16_t*)(aux + AUX_QG) + ci_ * 8192; g1 = *(const u32x4*)(qg + tid * 8); g2 = *(const u32x4*)(qg + (tid + 512) * 8); \
        const bf16_t* kd = (const bf16_t*)(aux + AUX_KDT) + ci_ * 8192; k1 = *(const u32x4*)(kd + tid * 8); k2 = *(const u32x4*)(kd + (tid + 512) * 8); \
        qk1 = *(const u32x4*)((const bf16_t*)(aux + AUX_QK) + ci_ * 4096 + tid * 8); \
        const bf16_t* ug = (const bf16_t*)(aux + AUX_UT) + ci_ * 8192; \
        _Pragma("unroll") for (int i = 0; i < 4; ++i) ut[i] = *(const u32x2*)(ug + (16 * (tnb4 + i) + l16) * 64 + 16 * tm + 4 * quad); \
        eg = ((const float*)(aux + AUX_EG))[ci_]; } while (0)
#define DN_STORE() do { \
        *(LAS u32x4*)(Ws + (tid >> 4) * 136 + (tid & 15) * 8) = w1; *(LAS u32x4*)(Ws + ((tid + 512) >> 4) * 136 + (tid & 15) * 8) = w2; \
        *(LAS u32x4*)(QGs + (tid >> 4) * 136 + (tid & 15) * 8) = g1; *(LAS u32x4*)(QGs + ((tid + 512) >> 4) * 136 + (tid & 15) * 8) = g2; \
        *(LAS u32x4*)(KDTs + (tid >> 3) * 72 + (tid & 7) * 8) = k1; *(LAS u32x4*)(KDTs + ((tid + 512) >> 3) * 72 + (tid & 7) * 8) = k2; \
        *(LAS u32x4*)(QKs + (tid >> 3) * 72 + (tid & 7) * 8) = qk1; } while (0)
    DN_LOAD(0);
    DN_STORE();
    const int t = 16 * tm + l16;
    for (int n = 0; n < 32; ++n) {
        __syncthreads();
        const float egc = eg; u32x2 utc[4];
#pragma unroll
        for (int i = 0; i < 4; ++i) utc[i] = ut[i];
        if (n + 1 < 32) DN_LOAD(n + 1);
        u32x2 gpre[4];
        { const bf16_t* gp_ = PROJ + (row0 + (size_t)n * 64 + t) * PW + 1536 + h * 128;
#pragma unroll
          for (int i = 0; i < 4; ++i) gpre[i] = *(const u32x2*)(gp_ + 16 * (tnb4 + i) + 4 * quad); }
        {
            f32x4 acc[4];
#pragma unroll
            for (int i = 0; i < 4; ++i) acc[i] = (f32x4){0.f, 0.f, 0.f, 0.f};
#pragma unroll
            for (int kx = 0; kx < 4; ++kx) { const bf16x8 a = ldfrag(Ws, 16 * tm + l16, 136, kx * 32 + quad * 8);
#pragma unroll
                for (int i = 0; i < 4; ++i) { const bf16x8 bq = ldfrag(ST, 16 * (tnb4 + i) + l16, 136, kx * 32 + quad * 8); acc[i] = MFMA16(a, bq, acc[i]); } }
#pragma unroll
            for (int i = 0; i < 4; ++i) { const float v0 = bflo(utc[i].x) - acc[i][0], v1 = bfhi(utc[i].x) - acc[i][1], v2 = bflo(utc[i].y) - acc[i][2], v3 = bfhi(utc[i].y) - acc[i][3];
                u32x2 o; o.x = cvt_pk_bf16(v0, v1); o.y = cvt_pk_bf16(v2, v3); *(LAS u32x2*)(VnT + (16 * (tnb4 + i) + l16) * 72 + 16 * tm + 4 * quad) = o; }
        }
        __syncthreads();
        f32x4 o2[4];
        {
#pragma unroll
            for (int i = 0; i < 4; ++i) o2[i] = (f32x4){0.f, 0.f, 0.f, 0.f};
#pragma unroll
            for (int kx = 0; kx < 4; ++kx) { const bf16x8 a = ldfrag(QGs, t, 136, kx * 32 + quad * 8);
#pragma unroll
                for (int i = 0; i < 4; ++i) { const bf16x8 bq = ldfrag(ST, 16 * (tnb4 + i) + l16, 136, kx * 32 + quad * 8); o2[i] = MFMA16(bq, a, o2[i]); } }
#pragma unroll
            for (int kx = 0; kx < 2; ++kx) { const bf16x8 a = ldfrag(QKs, t, 72, kx * 32 + quad * 8);
#pragma unroll
                for (int i = 0; i < 4; ++i) { const bf16x8 bq = ldfrag(VnT, 16 * (tnb4 + i) + l16, 72, kx * 32 + quad * 8); o2[i] = MFMA16(bq, a, o2[i]); } }
            float ssq = 0.f;
#pragma unroll
            for (int i = 0; i < 4; ++i) ssq += (o2[i][0] * o2[i][0] + o2[i][1] * o2[i][1]) + (o2[i][2] * o2[i][2] + o2[i][3] * o2[i][3]);
            ssq += __shfl_xor(ssq, 16); ssq += __shfl_xor(ssq, 32);
            if (quad == 0) red[t * 2 + (wave & 1)] = ssq;
        }
        {
#pragma unroll
            for (int tn = 0; tn < 8; ++tn) Sacc[tn] = Sacc[tn] * egc;
#pragma unroll
            for (int kx = 0; kx < 2; ++kx) { const bf16x8 a = ldfrag(KDTs, 16 * wave + l16, 72, kx * 32 + quad * 8);
#pragma unroll
                for (int tn = 0; tn < 8; ++tn) { const bf16x8 bq = ldfrag(VnT, 16 * tn + l16, 72, kx * 32 + quad * 8); Sacc[tn] = MFMA16(a, bq, Sacc[tn]); } }
        }
        __syncthreads();
#pragma unroll
        for (int tn = 0; tn < 8; ++tn) { u32x2 o; o.x = cvt_pk_bf16(Sacc[tn][0], Sacc[tn][1]); o.y = cvt_pk_bf16(Sacc[tn][2], Sacc[tn][3]); *(LAS u32x2*)(ST + (16 * tn + l16) * 136 + 16 * wave + 4 * quad) = o; }
        {
            const float rs = rsqrtf((red[t * 2] + red[t * 2 + 1]) * (1.0f / 128.0f) + 1e-6f);
            bf16_t* gp = PROJ + (row0 + (size_t)n * 64 + t) * PW + 1536 + h * 128;
#pragma unroll
            for (int i = 0; i < 4; ++i) { const int c0 = 16 * (tnb4 + i) + 4 * quad; const u32x2 gv = gpre[i]; const float g4[4] = {bflo(gv.x), bfhi(gv.x), bflo(gv.y), bfhi(gv.y)};
                const f32x4 nw = nwv[i]; float r4[4];
#pragma unroll
                for (int j = 0; j < 4; ++j) r4[j] = o2[i][j] * rs * nw[j] * siluf_(g4[j]);
                u32x2 ov; ov.x = cvt_pk_bf16(r4[0], r4[1]); ov.y = cvt_pk_bf16(r4[2], r4[3]); *(u32x2*)(gp + c0) = ov; }
        }
        if (n + 1 < 32) DN_STORE();
    }
    {
        float* so = p.out() + O_PS + sidx * 16384;
#pragma unroll
        for (int tn = 0; tn < 8; ++tn)
#pragma unroll
            for (int j = 0; j < 4; ++j) so[(16 * wave + 4 * quad + j) * 128 + 16 * tn + l16] = Sacc[tn][j];
    }
    __syncthreads();
#undef DN_LOAD
#undef DN_STORE
}
#define XB_TMO      128
#define XB_XCNT(j)  (256  + 64 * (j))
#define XB_XSUB(j)  (1280 + 64 * (j))
#define XB_XGEN(j)  (2304 + 64 * (j))
#define XB_TOP      3328
#define XB_TOPGEN   3392
#define XCD_BAR_WORDS 3456
#define XB_SPIN_CAP (1u << 18)

__device__ __forceinline__ unsigned xb_ld(unsigned* p)              { return __hip_atomic_load(p, __ATOMIC_RELAXED, __HIP_MEMORY_SCOPE_AGENT); }
__device__ __forceinline__ unsigned xb_add(unsigned* p, unsigned v) { return __hip_atomic_fetch_add(p, v, __ATOMIC_RELAXED, __HIP_MEMORY_SCOPE_AGENT); }
__device__ __forceinline__ unsigned xb_xcc_id() { return (unsigned)__builtin_amdgcn_s_getreg((3 << 11) | 20) & 0xFu; }
#define XB_SPIN(cond, bar) do { unsigned _sp = 0; while (cond) { __builtin_amdgcn_s_sleep(1); \
    if ((++_sp & 255u) == 0u) { if (xb_ld(&(bar)[XB_TMO])) break; if (_sp > XB_SPIN_CAP) { atomicAdd(&(bar)[XB_TMO], 1u); break; } } } } while (0)

struct XcdBarrier {
    unsigned* bar; unsigned x;
    volatile LAS unsigned* st;
};

__device__ __forceinline__ XcdBarrier xcd_barrier_post(unsigned* bar, volatile LAS unsigned* st) {
    XcdBarrier b; b.bar = bar; b.x = xb_xcc_id(); b.st = st;
    if (threadIdx.x == 0) (void)xb_add(&bar[XB_XCNT(b.x)], 1u);
    return b;
}
__device__ __forceinline__ void xcd_barrier_complete(unsigned* bar, unsigned x, unsigned& nloc, unsigned& nx) {
    const unsigned G = gridDim.x * gridDim.y * gridDim.z;
    unsigned sum, cnt, mine, sp = 0u;
    for (;;) {
        sum = 0u; cnt = 0u; mine = 0u;
#pragma unroll
        for (unsigned j = 0; j < 16; ++j) { const unsigned c = xb_ld(&bar[XB_XCNT(j)]); sum += c; cnt += (c > 0u) ? 1u : 0u; mine = (j == x) ? c : mine; }
        if (sum == G) break;
        __builtin_amdgcn_s_sleep(1);
        if ((++sp & 255u) == 0u) { if (xb_ld(&bar[XB_TMO])) break; if (sp > XB_SPIN_CAP) { atomicAdd(&bar[XB_TMO], 1u); break; } }
    }
    nloc = mine > 0u ? mine : 1u; nx = cnt > 0u ? cnt : 1u;
}

__device__ __forceinline__ void xcd_barrier(const XcdBarrier& b) {
    asm volatile("s_waitcnt vmcnt(0)" ::: "memory");
    __syncthreads();
    if (threadIdx.x == 0) {
        unsigned* bar = b.bar;
        __builtin_amdgcn_s_waitcnt(0);
        unsigned nloc = b.st[0], nx = b.st[1];
        if (nloc == 0u) { xcd_barrier_complete(bar, b.x, nloc, nx); b.st[0] = nloc; b.st[1] = nx; }
        const unsigned old = xb_add(&bar[XB_XSUB(b.x)], 1u);
        const unsigned gen = old / nloc;
        if (old + 1u == (gen + 1u) * nloc) {
            __builtin_amdgcn_fence(__ATOMIC_RELEASE, "agent");
            asm volatile("s_waitcnt vmcnt(0)" ::: "memory");
            const unsigned og = xb_add(&bar[XB_TOP], 1u);
            const unsigned tg = og / nx;
            if (og + 1u == (tg + 1u) * nx) xb_add(&bar[XB_TOPGEN], 1u);
            else XB_SPIN(xb_ld(&bar[XB_TOPGEN]) == tg, bar);
            __builtin_amdgcn_fence(__ATOMIC_ACQUIRE, "agent");
            xb_add(&bar[XB_XGEN(b.x)], 1u);
            asm volatile("s_waitcnt vmcnt(0)" ::: "memory");
        } else {
            XB_SPIN(xb_ld(&bar[XB_XGEN(b.x)]) == gen, bar);
            __builtin_amdgcn_fence(__ATOMIC_ACQUIRE, "agent");
            asm volatile("s_waitcnt vmcnt(0)" ::: "memory");
        }
    }
    __syncthreads();
}

__device__ __forceinline__ int next_item(unsigned* ctr, LAS int* slot) {
    __syncthreads();
    if (my_tid() == 0) *slot = (int)atomicAdd(ctr, 1u);
    __syncthreads();
    return __builtin_amdgcn_readfirstlane(*slot);
}

__device__ void run_phase(int ph, LAS unsigned char* lds) {
    lds = launder_lds(lds);
    DP p{(const LAS unsigned long long*)(lds + MISC_OFF + 64)};
    const int G = gridDim.x, bx = my_bid();
    bf16_t* X = (bf16_t*)(p.ws() + WS_X); bf16_t* PROJ = (bf16_t*)(p.ws() + WS_PROJ); bf16_t* MG = (bf16_t*)(p.ws() + WS_AUX); bf16_t* H = (bf16_t*)(p.ws() + WS_AUX);
    bf16_t* T1 = (bf16_t*)(p.ws() + WS_PROJ); bf16_t* U = (bf16_t*)(p.ws() + WS_PROJ); bf16_t* T2 = (bf16_t*)(p.ws() + WS_PROJ + OFF_T2);
    unsigned* ctr = (unsigned*)(p.ws() + WS_CTR); float* TS1 = (float*)(p.ws() + WS_AUX + (size_t)36 * 1024 * 1024); bf16_t* PZ = (bf16_t*)(p.ws() + WS_AUX + (size_t)62 * 1024 * 1024); float* TS2 = (float*)(p.ws() + WS_AUX + (size_t)36 * 1024 * 1024);
    if (ph == 0) { phase_prep(p, lds); return; }
    const int l = (ph - 1) / 9, s = (ph - 1) % 9;
    const bf16_t* WinT = (const bf16_t*)(p.ws() + WS_WIN) + (size_t)l * 9216 * 1024;
    if (s == 0) {
        pg8::Gemm g{X, WinT, NTOK, PW, DM, DM, 0, 0, DM}; pg8::Order S; S.init(NTOK, PW, 1, G, bx, DM);
        pg8::EpiBf16<0> E{PROJ, PW};
        pg8::gemm_phase(lds, g, S, E);
        phase_small(p, l, lds);
    } else if (s == 1) {
        LAS int* slot = (LAS int*)(lds + MISC_OFF);
        for (;;) {
            const int it = next_item(ctr + l * 4, slot);
            if (it >= 1024) break;
            dn_prep_item(p, l, it >> 7, (it >> 2) & 31, it & 3, lds);
        }
    } else if (s == 2) {
        if (bx < 32) scan_item<2>(p, l, bx >> 2, bx & 3, lds);
        else if (bx < 64) scan_item<1>(p, l, (bx - 32) >> 2, bx & 3, lds);
        else if (bx < 96) dn_scan_item(p, l, (bx - 64) >> 2, bx & 3, lds);
        else {
            pg8::Gemm g{X, WinT + (size_t)PW * 1024, NTOK, NG, DM, DM, 0, 0, DM}; pg8::Order S; S.init(NTOK, NG, 1, G - 96, bx - 96, DM);
            pg8::EpiGateU8 E{(unsigned char*)PROJ, p.ws() + WS_SGS};
            pg8::gemm_phase(lds, g, S, E);
        }
        { LAS int* slot = (LAS int*)(lds + MISC_OFF);
          for (;;) {
            const int j = next_item(ctr + l * 4 + 1, slot);
            if (j >= 1536) break;
            const int mix = j / 512, rem = j % 512, b = rem >> 2, h = rem & 3;
            if (mix == 0) rec_item<0>(p, l, false, b, h, lds); else if (mix == 1) rec_item<1>(p, l, false, b, h, lds); else rec_item<2>(p, l, false, b, h, lds);
           }
          if (l + 1 < NL) for (;;) {
            const int i = next_item(ctr + l * 4 + 2, slot);
            if (i >= 4992) break;
            prep_one_tile(p, layer_tile(l + 1, i), lds);
          } }
    } else if (s == 3) {
        pg8::Gemm g{PROJ + 1536, (const bf16_t*)(p.ws() + WS_WBR) + (size_t)l * 3 * 1024 * 512, NTOK, DM, 512, PW, 2048, 1024 * 512, 512}; pg8::Order S; S.init(NTOK, DM, 3, G, bx, 512, G == 256 ? -1 : 0);
        pg8::EpiMerge E{(const unsigned char*)PROJ, p.ws() + WS_SGS, MG, PZ};
        pg8::gemm_phase(lds, g, S, E);
    } else if (s == 4) {
        pg8::Gemm g{MG, (const bf16_t*)(p.ws() + WS_WOUT) + (size_t)l * 1024 * 1024, NTOK, DM, DM, DM, DM / 4, DM / 4, DM, PZ, 512 * 1024, 4}; pg8::Order S; S.init(NTOK, DM, 1, G, bx, DM, G == 256 ? 12 : 0, 4);
        pg8::EpiRes E{X, T1, TS1};
        pg8::gemm_phase(lds, g, S, E);
    } else if (s == 5) {
        phase_ln(T1, TS1, G == 256 ? 12 : 0, p.in(I_LN1G) + l * DM, p.in(I_LN1B) + l * DM, H, nullptr, nullptr);
    } else if (s == 6) {
        pg8::Gemm g{H, (const bf16_t*)(p.ws() + WS_WFF1) + (size_t)l * 4096 * 1024, NTOK, DFF, DM, DM, 0, 0, DM}; pg8::Order S; S.init(NTOK, DFF, 1, G, bx, DM);
        pg8::EpiBf16<1> E{U, DFF};
        pg8::gemm_phase(lds, g, S, E);
    } else if (s == 7) {
        pg8::Gemm g{U, (const bf16_t*)(p.ws() + WS_WFF2) + (size_t)l * 1024 * 4096, NTOK, DM, DFF, DFF, DFF / 16, DFF / 16, DFF, U + (size_t)NP * DFF, 0, 16}; pg8::Order S; S.init(NTOK, DM, 1, G, bx, DFF, G == 256 ? 16 : 0, 4);
        pg8::EpiRes E{H, T2, TS2};
        pg8::gemm_phase(lds, g, S, E);
    } else {
        const bool lastl = (l == NL - 1);
        phase_ln(T2, TS2, G == 256 ? 16 : 0, p.in(I_LN2G) + l * DM, p.in(I_LN2B) + l * DM, X, lastl ? p.out() + O_YP : nullptr, lastl ? p.out() + O_YS : nullptr);
    }
}

constexpr int NPHASE = 1 + 9 * NL;
__global__ void __launch_bounds__(512) mega(Params kp, int ph_lo, int ph_hi) {
    extern __shared__ __attribute__((aligned(16))) unsigned char lds_raw[];
    LAS unsigned char* lds = (LAS unsigned char*)lds_raw;
    cg::grid_group grid = cg::this_grid();
    LAS unsigned long long* tab = (LAS unsigned long long*)(lds + MISC_OFF + 64);
    if (threadIdx.x == 0) {
#pragma unroll
        for (int i = 0; i < 26; ++i) tab[i] = (unsigned long long)kp.in[i];
        tab[26] = (unsigned long long)kp.out; tab[27] = (unsigned long long)kp.ws; }
    if (threadIdx.x < 4) ((LAS unsigned*)(lds + MISC_OFF + 16))[threadIdx.x] = 0u;
    __syncthreads();
    const XcdBarrier xb = xcd_barrier_post((unsigned*)(kp.ws + WS_CTR + 1024), (volatile LAS unsigned*)(lds + MISC_OFF + 16));
    for (int ph = ph_lo; ph < ph_hi; ++ph) {
        run_phase(ph, lds);
        if (ph + 1 < ph_hi) {
            if (ph == ph_lo) grid.sync();
            else xcd_barrier(xb);
        }
    }
}

extern "C" void kernel_launch(void* const* d_in, const int* in_sizes, int n_in, void* d_out, int out_size, void* d_ws, size_t ws_size, hipStream_t stream) {
    static int grid = 0;
    if (grid == 0) {
        int dev = 0, cus = 0, per_cu = 0;
        (void)hipGetDevice(&dev);
        (void)hipDeviceGetAttribute(&cus, hipDeviceAttributeMultiprocessorCount, dev);
        (void)hipFuncSetAttribute((const void*)mega, hipFuncAttributeMaxDynamicSharedMemorySize, LDS_BYTES);
        (void)hipOccupancyMaxActiveBlocksPerMultiprocessor(&per_cu, (const void*)mega, 512, LDS_BYTES);
        if (per_cu < 1) per_cu = 1;
        grid = cus * per_cu;
        if (n_in != 26 || (long)out_size != O_END || ws_size < WS_END) { fprintf(stderr, "kernel_launch: unexpected sizes n_in %d out %d ws %zu (need %zu)\n", n_in, out_size, ws_size, (size_t)WS_END); }
    }
    (void)hipMemsetAsync((char*)d_ws + WS_CTR, 0, SZ_CTR, stream);
    Params p{};
    for (int i = 0; i < 26; ++i) p.in[i] = (const float*)d_in[i];
    p.out = (float*)d_out; p.ws = (unsigned char*)d_ws;
    int lo = 0, hi = NPHASE;
    void* args[] = {&p, &lo, &hi};
    hipError_t e = hipLaunchCooperativeKernel((const void*)mega, dim3(grid), dim3(512), args, LDS_BYTES, stream);
    if (e != hipSuccess) fprintf(stderr, "cooperative launch failed: %s (grid %d)\n", hipGetErrorString(e), grid);
}
```

```cpp
#include <hip/hip_runtime.h>
#include <hip/hip_cooperative_groups.h>
#include <cstdio>
namespace cg = cooperative_groups;

#define LAS __attribute__((address_space(3)))
typedef unsigned short bf16_t;
typedef short bf16x8 __attribute__((ext_vector_type(8)));
typedef float f32x4 __attribute__((ext_vector_type(4)));
typedef float f32x2 __attribute__((ext_vector_type(2)));
typedef unsigned u32x4 __attribute__((ext_vector_type(4)));
typedef unsigned u32x2 __attribute__((ext_vector_type(2)));

typedef __bf16 bf16x2_t __attribute__((ext_vector_type(2)));
__device__ __forceinline__ unsigned cvt_pk_bf16(float lo, float hi) { const f32x2 v = {lo, hi}; const bf16x2_t b = __builtin_convertvector(v, bf16x2_t); return __builtin_bit_cast(unsigned, b); }
__device__ __forceinline__ bf16_t f2bf(float f) { return (bf16_t)(cvt_pk_bf16(f, 0.f) & 0xffffu); }
__device__ __forceinline__ float bf2f(bf16_t b) { return __uint_as_float(((unsigned)b) << 16); }
__device__ __forceinline__ float bflo(unsigned w) { return __uint_as_float(w << 16); }
__device__ __forceinline__ float bfhi(unsigned w) { return __uint_as_float(w & 0xffff0000u); }
__device__ __forceinline__ float sigmoidf_(float x) { return __builtin_amdgcn_rcpf(1.0f + __expf(-x)); }
__device__ __forceinline__ float siluf_(float x) { return x * __builtin_amdgcn_rcpf(1.0f + __expf(-x)); }
__device__ __forceinline__ float softplusf_(float x) { return fmaxf(x, 0.f) + log1pf(__expf(-fabsf(x))); }
__device__ __forceinline__ float logsigmoidf_(float x) { return fminf(x, 0.f) - log1pf(__expf(-fabsf(x))); }

__device__ __forceinline__ int my_tid() { int t = threadIdx.x; asm volatile("" : "+v"(t)); return t; }
__device__ __forceinline__ int my_bid() { int t = blockIdx.x; asm volatile("" : "+s"(t)); return t; }
__device__ __forceinline__ LAS unsigned char* launder_lds(LAS unsigned char* q) { unsigned v = (unsigned)(unsigned long long)q; asm volatile("" : "+s"(v)); return (LAS unsigned char*)(unsigned long long)v; }
constexpr int NP = 16384, NTOK = 16896, DM = 1024, PW = 6144, NG = 3072, DFF = 4096, NL = 2, SEQ = 2048, NB = 8, NDB = 128;
constexpr float ALPHA = 1.41421356237f;
constexpr float DKS = 0.08838834764831845f;
enum { I_XP = 0, I_XS, I_SCONV, I_SS, I_SR, I_SC, I_SN, I_SM, I_WIN, I_CONVW, I_ALOG, I_DTB, I_DNW, I_IB, I_FB, I_MLW, I_WBA, I_WBB, I_WBC, I_WOUT, I_LN1G, I_LN1B, I_WFF1, I_WFF2, I_LN2G, I_LN2B };
constexpr long O_YP = 0, O_YS = O_YP + (long)NP * DM, O_PCONV = O_YS + 512L * DM, O_PS = O_PCONV + 2L * 8 * 3 * 1536, O_PR = O_PS + 2L * 8 * 4 * 16384, O_PC = O_PR + 2L * 8 * 4 * 16384,
               O_PN = O_PC + 2L * 8 * 4 * 16384, O_PM = O_PN + 2L * 8 * 4 * 128, O_SCONV = O_PM + 2L * 8 * 4, O_SS = O_SCONV + 2L * 128 * 3 * 1536, O_SR = O_SS + 2L * 128 * 4 * 16384,
               O_SC = O_SR + 2L * 128 * 4 * 16384, O_SN = O_SC + 2L * 128 * 4 * 16384, O_SM = O_SN + 2L * 128 * 4 * 128, O_END = O_SM + 2L * 128 * 4;
static_assert(O_END == 72172608L, "output size");
constexpr size_t WS_WIN = 0, SZ_WIN = (size_t)NL * 9216 * 1024 * 2;
constexpr size_t WS_WBR = WS_WIN + SZ_WIN, SZ_WBR = (size_t)NL * 3 * 1024 * 512 * 2;
constexpr size_t WS_WOUT = WS_WBR + SZ_WBR, SZ_WOUT = (size_t)NL * 1024 * 1024 * 2;
constexpr size_t WS_WFF1 = WS_WOUT + SZ_WOUT, SZ_WFF = (size_t)NL * 4096 * 1024 * 2;
constexpr size_t WS_WFF2 = WS_WFF1 + SZ_WFF;
constexpr size_t WS_X = WS_WFF2 + SZ_WFF, SZ_X = (size_t)NTOK * DM * 2;
constexpr size_t WS_PROJ = WS_X + SZ_X, SZ_PROJ = (size_t)NTOK * PW * 2;
constexpr size_t WS_AUX = WS_PROJ + SZ_PROJ, SZ_AUX = (size_t)80 * 1024 * 1024;
constexpr size_t WS_SMALL = WS_AUX + SZ_AUX, SZ_SMALL = (size_t)NTOK * 16 * 4;
constexpr size_t WS_ROPE = WS_SMALL + SZ_SMALL, SZ_ROPE = (size_t)2052 * 64 * 2 * 4;
constexpr size_t WS_CTR = WS_ROPE + SZ_ROPE, SZ_CTR = 16384;
constexpr size_t WS_SGS = WS_CTR + SZ_CTR, SZ_SGS = (size_t)512 * 3072;
constexpr size_t WS_TS1 = WS_SGS + SZ_SGS, SZ_TSLAB = (size_t)512 * 1024 * 4;
constexpr size_t WS_TS2 = WS_TS1 + 4 * SZ_TSLAB;
constexpr size_t WS_END = WS_TS2 + 8 * SZ_TSLAB;
static_assert(WS_END <= (size_t)439575680, "workspace");
constexpr size_t OFF_T2 = (size_t)NTOK * DFF * 2;
static_assert(OFF_T2 + (size_t)NTOK * DM * 4 <= SZ_PROJ, "T2 fits");
constexpr size_t AUX_W = 0, AUX_UT = AUX_W + (size_t)1024 * 16384, AUX_QG = AUX_UT + (size_t)1024 * 16384, AUX_KDT = AUX_QG + (size_t)1024 * 16384, AUX_QK = AUX_KDT + (size_t)1024 * 16384, AUX_EG = AUX_QK + (size_t)1024 * 8192;
static_assert(AUX_EG + 4096 <= SZ_AUX, "aux");

constexpr int LDS_BYTES = 131072 + 1024;
constexpr int MISC_OFF = 131072;

struct Params { const float* in[26]; float* out; unsigned char* ws; };
__device__ __forceinline__ unsigned long long ld_uniform64(const LAS unsigned long long* a) { const unsigned long long v = *a; const unsigned lo = __builtin_amdgcn_readfirstlane((unsigned)v), hi = __builtin_amdgcn_readfirstlane((unsigned)(v >> 32)); return ((unsigned long long)hi << 32) | lo; }
struct DP { const LAS unsigned long long* tab;
    __device__ __forceinline__ const float* in(int i) const { return (const float*)(const __attribute__((address_space(1))) float*)ld_uniform64(tab + i); }
    __device__ __forceinline__ float* out() const { return (float*)(__attribute__((address_space(1))) float*)ld_uniform64(tab + 26); }
    __device__ __forceinline__ unsigned char* ws() const { return (unsigned char*)(__attribute__((address_space(1))) unsigned char*)ld_uniform64(tab + 27); } };
namespace pg8 {
constexpr int BM = 256, BK = 64, HALF = 128, HTB = HALF * BK * 2, STAGE_BYTES = 8 * HTB, NXCD = 8, WGM = 8;
__host__ __device__ __forceinline__ int lds_byte(int r, int c) { const int st = (r >> 4) * 2 + (c >> 5), rr = r & 15, cc = c & 31, ob = rr * 64 + cc * 2; return st * 1024 + (ob ^ (((ob >> 9) & 1) << 5)); }
__host__ __device__ __forceinline__ void stage_rc(int b, int& R, int& C) { const int st = b / 1024, sb = b % 1024, swz = sb ^ (((sb >> 9) & 1) << 5); R = (st >> 1) * 16 + swz / 64; C = (st & 1) * 32 + (swz % 64) / 2; }
__host__ __device__ __forceinline__ int perm32(int rho) { const int n = rho >> 4, i = rho & 15; return 8 * (i >> 2) + 4 * n + (i & 3); }

struct Unit { int pm, pn, z, kind, nt; };
struct Gemm { const bf16_t* A; const bf16_t* Bt; int M, N, K, lda; long zA, zB; int ldb; const bf16_t* A2; long zA2; int kdiv; };

struct Order {
    int nM, nN, nz, nwg, G, c, ntf, ksplit, ntp;
    __device__ void init(int M, int N, int nz_, int G_, int c_, int K, int ksplit_ = 0, int ntp_ = 0) { nM = M / BM; nN = N / BM; nz = nz_; nwg = nM * nN; G = G_; c = c_; ntf = K / BK; ksplit = ksplit_; ntp = ntp_; }
    __device__ bool next(int i, Unit& u) const {
        long L;
        if (ksplit == 0) { const int ti = i / nz; u.z = i - ti * nz; u.kind = 0; u.nt = ntf; L = (long)ti * G + c; if (c < 0 || L >= nwg) return false; }
        else {
            if (ksplit > 0) {
                if (i == 0) { u.z = 0; u.kind = 0; u.nt = ntf; L = c; }
                else if (i == 1 && c < 8 * ksplit) { const int j = c / ksplit; u.z = c - j * ksplit; u.kind = 1; u.nt = ntp; u.pm = 64 + (j >> 2); u.pn = j & 3; return true; }
                else return false;
            } else {
                if (i < nz) { u.z = i; u.kind = 0; u.nt = ntf; L = c; }
                else if (i == nz && c < 8 * nz) { const int j = c / nz; u.z = c - j * nz; u.kind = 2; u.nt = ntf; u.pm = 64 + (j >> 2); u.pn = j & 3; return true; }
                else return false;
            }
            int wgid = (int)L; { const int nw = 256, q = nw / NXCD, xcd = wgid % NXCD, off = wgid / NXCD; wgid = xcd * q + off; }
            const int nig = WGM * 4, gid = wgid / nig, fm = gid * WGM;
            u.pm = fm + ((wgid % nig) % WGM); u.pn = (wgid % nig) / WGM; return true;
        }
        int wgid = (int)L; { const int q = nwg / NXCD, r = nwg % NXCD, xcd = wgid % NXCD, off = wgid / NXCD; wgid = (xcd < r ? xcd * (q + 1) : r * (q + 1) + (xcd - r) * q) + off; }
        const int nig = WGM * nN, gid = wgid / nig, fm = gid * WGM, gsz = (nM - fm) < WGM ? (nM - fm) : WGM;
        u.pm = fm + ((wgid % nig) % gsz); u.pn = (wgid % nig) / gsz; return true;
    }
};

template <class Epi>
__device__ __forceinline__ void gemm_phase(LAS unsigned char* lds, const Gemm g, const Order& S, const Epi& E) {
    lds = launder_lds(lds);
    int tid_l = threadIdx.x; asm volatile("" : "+v"(tid_l));
    const int tid = tid_l, wid = __builtin_amdgcn_readfirstlane(tid >> 6), lane = tid & 63, wr = wid >> 2, wc = wid & 3, fr = lane & 15, fq = lane >> 4;
    const int K = g.ldb, lda = g.lda;
    unsigned voffA[2], voffB[2];
#pragma unroll
    for (int i = 0; i < 2; ++i) { int R, C; stage_rc(tid * 16 + i * 8192, R, C); const int Rb = Epi::PERM ? ((R & ~31) + perm32(R & 31)) : R;
        voffA[i] = (unsigned)(R * lda + C) * 2u; voffB[i] = (unsigned)(Rb * K + C) * 2u; }
    const size_t kstep = (size_t)(BK * 2);
    const size_t hstepA = (size_t)HALF * lda * 2, hstepB = (size_t)HALF * K * 2;
    const size_t tstepA = 2 * hstepA, tstepB = 2 * hstepB;
    const unsigned ldsw = (unsigned)wid * 1024u;
    const int aoff = lds_byte(wr * 64 + fr, fq * 8), boff = lds_byte(wc * 32 + fr, fq * 8);
#define PG8_SA(b, h) (((b) * 2 + (h)) * HTB)
#define PG8_SB(b, h) ((4 + (b) * 2 + (h)) * HTB)
#define PG8_STAGE(bufoff, gbase, voff) do { _Pragma("unroll") for (int _i = 0; _i < 2; ++_i) \
        __builtin_amdgcn_global_load_lds((const unsigned*)((const char*)(gbase) + (voff)[_i]), (LAS unsigned*)(lds + (bufoff) + ldsw + _i * 8192), 16, 0, 0); } while (0)
#define PG8_LDA(dst, b, h) do { _Pragma("unroll") for (int m = 0; m < 4; ++m) _Pragma("unroll") for (int k = 0; k < 2; ++k) dst[m][k] = *(const LAS bf16x8*)(lds + PG8_SA(b, h) + aoff + m * 2048 + k * 1024); } while (0)
#define PG8_LDB(dst, b, h) do { _Pragma("unroll") for (int n = 0; n < 2; ++n) _Pragma("unroll") for (int k = 0; k < 2; ++k) dst[n][k] = *(const LAS bf16x8*)(lds + PG8_SB(b, h) + boff + n * 2048 + k * 1024); } while (0)
#define PG8_MMA(ai, bj, At, Bt) do { __builtin_amdgcn_s_setprio(1); _Pragma("unroll") for (int m = 0; m < 4; ++m) _Pragma("unroll") for (int n = 0; n < 2; ++n) _Pragma("unroll") for (int k = 0; k < 2; ++k) \
        acc[ai][bj][m][n] = __builtin_amdgcn_mfma_f32_16x16x32_bf16(Bt[n][k], At[m][k], acc[ai][bj][m][n], 0, 0, 0); __builtin_amdgcn_s_setprio(0); } while (0)
#define PG8_WAIT_V(n) asm volatile("s_waitcnt vmcnt(" #n ")" ::: "memory")
#define PG8_WAIT_L(n) asm volatile("s_waitcnt lgkmcnt(" #n ")" ::: "memory")
#define PG8_BAR __builtin_amdgcn_s_barrier()
#define PG8_SCHED __builtin_amdgcn_sched_barrier(0)
    Unit cur, nxt; int ui = 0;
    if (!S.next(0, cur)) return;
    int nt = cur.nt;
    f32x4 acc[2][2][4][2];
#pragma unroll
    for (int a = 0; a < 2; ++a)
#pragma unroll
        for (int b = 0; b < 2; ++b)
#pragma unroll
            for (int m = 0; m < 4; ++m)
#pragma unroll
                for (int n = 0; n < 2; ++n) acc[a][b][m][n] = (f32x4){0.f, 0.f, 0.f, 0.f};
    bf16x8 At[4][2], B0[2][2], B1[2][2];
#define PG8_APTR(u_) ((u_).kind == 1 ? (const char*)(g.A2 + (size_t)((u_).z / g.kdiv) * g.zA2 + (size_t)((u_).z % g.kdiv) * g.zA) + (size_t)((u_).pm - 64) * tstepA : (const char*)(g.A + (size_t)(u_).z * g.zA) + (size_t)(u_).pm * tstepA)
#define PG8_BPTR(u_) ((const char*)(g.Bt + (size_t)((u_).kind == 1 ? (u_).z % g.kdiv : (u_).z) * g.zB) + (size_t)(u_).pn * tstepB)
    const char* cA = PG8_APTR(cur); const char* cB = PG8_BPTR(cur);
    PG8_STAGE(PG8_SB(0, 0), cB, voffB); PG8_STAGE(PG8_SA(0, 0), cA, voffA); PG8_STAGE(PG8_SB(0, 1), cB + hstepB, voffB); PG8_STAGE(PG8_SA(0, 1), cA + hstepA, voffA);
    if (wr == 1) PG8_BAR;
    PG8_WAIT_V(4); PG8_BAR;
    PG8_STAGE(PG8_SB(1, 0), cB + kstep, voffB); PG8_STAGE(PG8_SA(1, 0), cA + kstep, voffA); PG8_STAGE(PG8_SB(1, 1), cB + hstepB + kstep, voffB);
    PG8_WAIT_V(6); PG8_BAR;
    for (;;) {
        const bool has_next = S.next(ui + 1, nxt);
        const char* nA = has_next ? PG8_APTR(nxt) : cA; const char* nB = has_next ? PG8_BPTR(nxt) : cB;
        for (int t = 0; t < nt; t += 2) {
            const bool last = (t == nt - 2);
            const char* a1 = cA + (size_t)(t + 1) * kstep;
            const char* a2 = last ? nA : cA + (size_t)(t + 2) * kstep; const char* b2 = last ? nB : cB + (size_t)(t + 2) * kstep;
            const char* a3 = a2 + kstep; const char* b3 = b2 + kstep;
            PG8_LDB(B0, 0, 0); PG8_SCHED; PG8_LDA(At, 0, 0); PG8_STAGE(PG8_SA(1, 1), a1 + hstepA, voffA);
            PG8_WAIT_L(8); PG8_BAR; PG8_WAIT_L(0); PG8_MMA(0, 0, At, B0); PG8_BAR; PG8_SCHED;
            PG8_LDB(B1, 0, 1); PG8_STAGE(PG8_SB(0, 0), b2, voffB);
            PG8_BAR; PG8_WAIT_L(0); PG8_MMA(0, 1, At, B1); PG8_BAR;
            PG8_LDA(At, 0, 1); PG8_STAGE(PG8_SA(0, 0), a2, voffA);
            PG8_BAR; PG8_WAIT_L(0); PG8_MMA(1, 0, At, B0); PG8_BAR; PG8_SCHED;
            PG8_STAGE(PG8_SB(0, 1), b2 + hstepB, voffB);
            PG8_WAIT_V(6); PG8_BAR; PG8_MMA(1, 1, At, B1); PG8_BAR;
            PG8_LDB(B0, 1, 0); PG8_SCHED; PG8_LDA(At, 1, 0); PG8_STAGE(PG8_SA(0, 1), a2 + hstepA, voffA);
            PG8_WAIT_L(8); PG8_BAR; PG8_WAIT_L(0); PG8_MMA(0, 0, At, B0); PG8_BAR; PG8_SCHED;
            PG8_LDB(B1, 1, 1); PG8_STAGE(PG8_SB(1, 0), b3, voffB);
            PG8_BAR; PG8_WAIT_L(0); PG8_MMA(0, 1, At, B1); PG8_BAR;
            PG8_LDA(At, 1, 1); PG8_STAGE(PG8_SA(1, 0), a3, voffA);
            PG8_BAR; PG8_WAIT_L(0); PG8_MMA(1, 0, At, B0); PG8_BAR; PG8_SCHED;
            PG8_STAGE(PG8_SB(1, 1), b3 + hstepB, voffB);
            PG8_WAIT_V(6); PG8_BAR; PG8_MMA(1, 1, At, B1); PG8_BAR;
        }
        E(acc, cur, wr, wc, fr, fq);
        if (!has_next) break;
#pragma unroll
        for (int a = 0; a < 2; ++a)
#pragma unroll
            for (int b = 0; b < 2; ++b)
#pragma unroll
                for (int m = 0; m < 4; ++m)
#pragma unroll
                    for (int n = 0; n < 2; ++n) acc[a][b][m][n] = (f32x4){0.f, 0.f, 0.f, 0.f};
        cur = nxt; cA = nA; cB = nB; ++ui; nt = cur.nt;
    }
    PG8_WAIT_V(0);
    if (wr == 0) PG8_BAR;
    PG8_BAR;
#undef PG8_APTR
#undef PG8_BPTR
#undef PG8_SA
#undef PG8_SB
#undef PG8_STAGE
#undef PG8_LDA
#undef PG8_LDB
#undef PG8_MMA
#undef PG8_WAIT_V
#undef PG8_WAIT_L
#undef PG8_BAR
#undef PG8_SCHED
}
}
namespace pg8 {
template <int ACT  > struct EpiBf16 {
    static constexpr bool PERM = true;
    bf16_t* O; int ldc;
    __device__ __forceinline__ void operator()(const f32x4 (&acc)[2][2][4][2], const Unit& u, int wr, int wc, int fr, int fq) const {
        const int row0 = u.pm * BM + wr * 64 + fr;
        int colt = u.pn * BM; if (ACT == 2) colt = (u.pn >> 2) * 2048 + (u.pn & 3) * 256;
        const int col0 = colt + wc * 32 + 8 * fq;
#pragma unroll
        for (int ai = 0; ai < 2; ++ai)
#pragma unroll
            for (int m = 0; m < 4; ++m) { bf16_t* rowp = O + (size_t)(row0 + ai * HALF + m * 16) * ldc + col0;
#pragma unroll
                for (int bj = 0; bj < 2; ++bj) { f32x4 v0 = acc[ai][bj][m][0], v1 = acc[ai][bj][m][1];
                    if (ACT == 1) {
#pragma unroll
                        for (int j = 0; j < 4; ++j) { const float a = fmaxf(v0[j], 0.f), b = fmaxf(v1[j], 0.f); v0[j] = a * a; v1[j] = b * b; } }
                    if (ACT == 2) {
#pragma unroll
                        for (int j = 0; j < 4; ++j) { v0[j] = sigmoidf_(v0[j]); v1[j] = sigmoidf_(v1[j]); } }
                    u32x4 w; w.x = cvt_pk_bf16(v0[0], v0[1]); w.y = cvt_pk_bf16(v0[2], v0[3]); w.z = cvt_pk_bf16(v1[0], v1[1]); w.w = cvt_pk_bf16(v1[2], v1[3]);
                    *(u32x4*)(rowp + bj * HALF) = w; } }
    }
};
struct EpiGateU8 {
    static constexpr bool PERM = true;
    unsigned char* SG8; unsigned char* SGS;
    __device__ __forceinline__ void operator()(const f32x4 (&acc)[2][2][4][2], const Unit& u, int wr, int wc, int fr, int fq) const {
        const int row0 = u.pm * BM + wr * 64 + fr, col0 = u.pn * BM + wc * 32 + 8 * fq; const bool smp = u.pm >= 64;
#pragma unroll
        for (int ai = 0; ai < 2; ++ai)
#pragma unroll
            for (int m = 0; m < 4; ++m) { const size_t rr = (size_t)(row0 + ai * HALF + m * 16); unsigned char* rowp = smp ? SGS + (rr - NP) * 3072 + col0 : SG8 + rr * (PW * 2) + col0;
#pragma unroll
                for (int bj = 0; bj < 2; ++bj) { const f32x4 v0 = acc[ai][bj][m][0], v1 = acc[ai][bj][m][1]; unsigned q[8];
#pragma unroll
                    for (int j = 0; j < 4; ++j) { q[j] = (unsigned)(sigmoidf_(v0[j]) * 255.0f + 0.5f); q[4 + j] = (unsigned)(sigmoidf_(v1[j]) * 255.0f + 0.5f); }
                    u32x2 w; w.x = q[0] | (q[1] << 8) | (q[2] << 16) | (q[3] << 24); w.y = q[4] | (q[5] << 8) | (q[6] << 16) | (q[7] << 24);
                    *(u32x2*)(rowp + bj * HALF) = w; } }
    }
};
struct EpiMerge {
    static constexpr bool PERM = true;
    const unsigned char* SG8; const unsigned char* SGS; bf16_t* MG; bf16_t* P;
    __device__ __forceinline__ void operator()(const f32x4 (&acc)[2][2][4][2], const Unit& u, int wr, int wc, int fr, int fq) const {
        const int row0 = u.pm * BM + wr * 64 + fr, col0 = u.pn * BM + wc * 32 + 8 * fq; const bool smp = u.pm >= 64;
        const float S8 = 1.0f / 255.0f;
#pragma unroll
        for (int ai = 0; ai < 2; ++ai) {
            u32x2 sgv[4][2]; u32x4 pvv[4][2];
#pragma unroll
            for (int m = 0; m < 4; ++m) { const size_t r = (size_t)(row0 + ai * HALF + m * 16);
#pragma unroll
                for (int bj = 0; bj < 2; ++bj) { const int c = col0 + bj * HALF;
                    sgv[m][bj] = *(const u32x2*)(smp ? SGS + (r - NP) * 3072 + u.z * 1024 + c : SG8 + r * (PW * 2) + u.z * 1024 + c);
                    pvv[m][bj] = (u32x4){0u, 0u, 0u, 0u}; if (u.z > 0 && u.kind == 0) pvv[m][bj] = *(const u32x4*)(MG + r * DM + c); } }
#pragma unroll
            for (int m = 0; m < 4; ++m) { const size_t r = (size_t)(row0 + ai * HALF + m * 16);
#pragma unroll
                for (int bj = 0; bj < 2; ++bj) { const int c = col0 + bj * HALF; const u32x2 sg = sgv[m][bj]; const u32x4 pv = pvv[m][bj];
                    const f32x4 v0 = acc[ai][bj][m][0], v1 = acc[ai][bj][m][1];
                    float o[8];
                    o[0] = bflo(pv.x) + (float)(sg.x & 255u) * S8 * v0[0]; o[1] = bfhi(pv.x) + (float)((sg.x >> 8) & 255u) * S8 * v0[1]; o[2] = bflo(pv.y) + (float)((sg.x >> 16) & 255u) * S8 * v0[2]; o[3] = bfhi(pv.y) + (float)(sg.x >> 24) * S8 * v0[3];
                    o[4] = bflo(pv.z) + (float)(sg.y & 255u) * S8 * v1[0]; o[5] = bfhi(pv.z) + (float)((sg.y >> 8) & 255u) * S8 * v1[1]; o[6] = bflo(pv.w) + (float)((sg.y >> 16) & 255u) * S8 * v1[2]; o[7] = bfhi(pv.w) + (float)(sg.y >> 24) * S8 * v1[3];
                    u32x4 w; w.x = cvt_pk_bf16(o[0], o[1]); w.y = cvt_pk_bf16(o[2], o[3]); w.z = cvt_pk_bf16(o[4], o[5]); w.w = cvt_pk_bf16(o[6], o[7]);
                    if (u.kind == 2) *(u32x4*)(P + (size_t)u.z * (512 * 1024) + (r - NP) * DM + c) = w; else *(u32x4*)(MG + r * DM + c) = w; } }
        }
    }
};
struct EpiRes {
    static constexpr bool PERM = true;
    const bf16_t* R; bf16_t* T; float* TS;
    __device__ __forceinline__ void operator()(const f32x4 (&acc)[2][2][4][2], const Unit& u, int wr, int wc, int fr, int fq) const {
        const int row0 = u.pm * BM + wr * 64 + fr, col0 = u.pn * BM + wc * 32 + 8 * fq;
        const float al = (u.kind == 0 || u.z == 0) ? ALPHA : 0.f;
        u32x4 rv[8][2];
#pragma unroll
        for (int g = 0; g < 8; ++g) { const size_t off = (size_t)(row0 + (g >> 2) * HALF + (g & 3) * 16) * DM + col0;
#pragma unroll
            for (int bj = 0; bj < 2; ++bj) rv[g][bj] = *(const u32x4*)(R + off + bj * HALF); }
#pragma unroll
        for (int g = 0; g < 8; ++g) { const int ai = g >> 2, m = g & 3; const size_t off = (size_t)(row0 + ai * HALF + m * 16) * DM + col0;
#pragma unroll
            for (int bj = 0; bj < 2; ++bj) { const f32x4 a0 = acc[ai][bj][m][0], a1 = acc[ai][bj][m][1]; const u32x4 r4 = rv[g][bj];
                f32x4 o0, o1;
                o0[0] = al * bflo(r4.x) + a0[0]; o0[1] = al * bfhi(r4.x) + a0[1]; o0[2] = al * bflo(r4.y) + a0[2]; o0[3] = al * bfhi(r4.y) + a0[3];
                o1[0] = al * bflo(r4.z) + a1[0]; o1[1] = al * bfhi(r4.z) + a1[1]; o1[2] = al * bflo(r4.w) + a1[2]; o1[3] = al * bfhi(r4.w) + a1[3];
                if (u.kind == 1) { float* tp = TS + (size_t)u.z * (512 * 1024) - (size_t)NP * DM + off + bj * HALF; *(f32x4*)tp = o0; *(f32x4*)(tp + 4) = o1; }
                else { u32x4 w; w.x = cvt_pk_bf16(o0[0], o0[1]); w.y = cvt_pk_bf16(o0[2], o0[3]); w.z = cvt_pk_bf16(o1[0], o1[1]); w.w = cvt_pk_bf16(o1[2], o1[3]); *(u32x4*)(T + off + bj * HALF) = w; } } }
    }
};
}
__device__ const double INVF_TAB[64] = {1.0, 0.8639884421904872, 0.7464760282387446, 0.6449466718349793, 0.5572264607350911, 0.4814372300171723, 0.4159562095110165, 0.35938136364028433, 0.3105013285433559, 0.26826956374857486, 0.2317818064466077, 0.20025680531542636, 0.1730195682307726, 0.14948690978871287, 0.12915496453195024, 0.11158839852149276, 0.09641107502718904, 0.083298055951679, 0.07196855883385066, 0.062180004100288046, 0.05372280579965271, 0.04641588408923615, 0.04010278807514057, 0.03464834599094895, 0.029935770990762976, 0.02586416058779556, 0.022346336198178787, 0.019306976531752063, 0.016681004863249332, 0.01441219565322053, 0.012451970684591487, 0.010758358938547867, 0.009295095387898274, 0.008030855121976314, 0.006938566125329044, 0.005994841040503793, 0.005179473460621423, 0.004475005283380656, 0.0038663529099118386, 0.003340484284901384, 0.002886139862987199, 0.0024935915269452234, 0.002154434295785405, 0.0018614063629509262, 0.0016082336113996364, 0.0013894952764291722, 0.0012005078799085084, 0.0010372249507937684, 0.0008961503848114063, 0.0007742635882245655, 0.0006689548029112771, 0.0005779692279785651, 0.0004993587414820355, 0.0004314401885488794, 0.00037275934279762493, 0.00032205976942079685, 0.0002782559232477479, 0.00024040990578147253, 0.00020771138354670873, 0.00017946023777449892, 0.00015505157392992585, 0.00013396277011711087, 0.00011574228705063282, 0.0001};
struct TileDesc { const float* src; bf16_t* dst; int ldsrc, ldd; };
__device__ __forceinline__ TileDesc prep_tile(const DP& p, int j) {
    TileDesc d;
    if (j < 4608) { const int l = j / 2304, rem = j % 2304, kt = rem & 15, nt = rem >> 4; const int n0 = nt * 64;
        const int c0 = n0 < 2048 ? n0 : (n0 < 6144 ? n0 + 8 : n0 + 16);
        d.src = p.in(I_WIN) + (size_t)l * 1024 * 9232 + (size_t)(kt * 64) * 9232 + c0; d.ldsrc = 9232; d.dst = (bf16_t*)(p.ws() + WS_WIN) + (size_t)l * 9216 * 1024 + (size_t)n0 * 1024 + kt * 64; d.ldd = 1024; }
    else if (j < 5376) { const int idx = j - 4608, l = idx / 384, rem = idx % 384, b = rem / 128, rem2 = rem % 128, kt = rem2 & 7, nt = rem2 >> 3;
        d.src = p.in(I_WBA + b) + (size_t)l * 512 * 1024 + (size_t)(kt * 64) * 1024 + nt * 64; d.ldsrc = 1024; d.dst = (bf16_t*)(p.ws() + WS_WBR) + (size_t)(l * 3 + b) * 1024 * 512 + (size_t)(nt * 64) * 512 + kt * 64; d.ldd = 512; }
    else if (j < 5888) { const int idx = j - 5376, l = idx / 256, rem = idx % 256, kt = rem & 15, nt = rem >> 4;
        d.src = p.in(I_WOUT) + (size_t)l * 1024 * 1024 + (size_t)(kt * 64) * 1024 + nt * 64; d.ldsrc = 1024; d.dst = (bf16_t*)(p.ws() + WS_WOUT) + (size_t)l * 1024 * 1024 + (size_t)(nt * 64) * 1024 + kt * 64; d.ldd = 1024; }
    else if (j < 7936) { const int idx = j - 5888, l = idx / 1024, rem = idx % 1024, kt = rem & 15, nt = rem >> 4;
        d.src = p.in(I_WFF1) + (size_t)l * 1024 * 4096 + (size_t)(kt * 64) * 4096 + nt * 64; d.ldsrc = 4096; d.dst = (bf16_t*)(p.ws() + WS_WFF1) + (size_t)l * 4096 * 1024 + (size_t)(nt * 64) * 1024 + kt * 64; d.ldd = 1024; }
    else { const int idx = j - 7936, l = idx / 1024, rem = idx % 1024, kt = rem & 63, nt = rem >> 6;
        d.src = p.in(I_WFF2) + (size_t)l * 4096 * 1024 + (size_t)(kt * 64) * 1024 + nt * 64; d.ldsrc = 1024; d.dst = (bf16_t*)(p.ws() + WS_WFF2) + (size_t)l * 1024 * 4096 + (size_t)(nt * 64) * 4096 + kt * 64; d.ldd = 4096; }
    return d;
}
__device__ __forceinline__ int layer_tile(int l, int i) {
    if (i < 2304) return l * 2304 + i;
    if (i < 2688) return 4608 + l * 384 + (i - 2304);
    if (i < 2944) return 5376 + l * 256 + (i - 2688);
    if (i < 3968) return 5888 + l * 1024 + (i - 2944);
    return 7936 + l * 1024 + (i - 3968);
}
__device__ void prep_one_tile(const DP& p, int j, LAS unsigned char* lds) {
    lds = launder_lds(lds);
    LAS float* b = (LAS float*)lds; const int tid = my_tid();
    const TileDesc d = prep_tile(p, j);
    float cur[8];
#pragma unroll
    for (int i = 0; i < 8; ++i) { const int idx = tid + i * 512, r = idx >> 6, c = idx & 63; cur[i] = d.src[(size_t)r * d.ldsrc + c]; }
    __syncthreads();
#pragma unroll
    for (int i = 0; i < 8; ++i) { const int idx = tid + i * 512, r = idx >> 6, c = idx & 63; b[r * 65 + c] = cur[i]; }
    __syncthreads();
#pragma unroll
    for (int i = 0; i < 4; ++i) { const int idx = tid + i * 512, n = idx >> 5, kp = idx & 31;
        *(unsigned*)(d.dst + (size_t)n * d.ldd + 2 * kp) = cvt_pk_bf16(b[(2 * kp) * 65 + n], b[(2 * kp + 1) * 65 + n]); }
}
__device__ void phase_prep(const DP& p, LAS unsigned char* lds) {
    lds = launder_lds(lds);
    LAS float* buf = (LAS float*)lds;
    const int G = gridDim.x, tid0 = my_tid(), bid0 = my_bid();
    const int tid = tid0;
    float cur[8]; TileDesc dc, dn; int par = 0;
    if (bid0 < 4992) { dc = prep_tile(p, layer_tile(0, bid0));
#pragma unroll
        for (int i = 0; i < 8; ++i) { const int idx = tid + i * 512, r = idx >> 6, c = idx & 63; cur[i] = dc.src[(size_t)r * dc.ldsrc + c]; } }
    for (int j = bid0; j < 4992; j += G) {
        float nxt[8]; const bool hn = j + G < 4992;
        if (hn) { dn = prep_tile(p, layer_tile(0, j + G));
#pragma unroll
            for (int i = 0; i < 8; ++i) { const int idx = tid + i * 512, r = idx >> 6, c = idx & 63; nxt[i] = dn.src[(size_t)r * dn.ldsrc + c]; } }
        LAS float* b = buf + par * (64 * 65);
#pragma unroll
        for (int i = 0; i < 8; ++i) { const int idx = tid + i * 512, r = idx >> 6, c = idx & 63; b[r * 65 + c] = cur[i]; }
        __syncthreads();
#pragma unroll
        for (int i = 0; i < 4; ++i) { const int idx = tid + i * 512, n = idx >> 5, kp = idx & 31;
            *(unsigned*)(dc.dst + (size_t)n * dc.ldd + 2 * kp) = cvt_pk_bf16(b[(2 * kp) * 65 + n], b[(2 * kp + 1) * 65 + n]); }
        if (hn) {
#pragma unroll
            for (int i = 0; i < 8; ++i) cur[i] = nxt[i];
            dc = dn; }
        par ^= 1;
    }
    __syncthreads();
    const size_t gtid = (size_t)bid0 * 512 + tid0, gsz = (size_t)G * 512;
    bf16_t* X = (bf16_t*)(p.ws() + WS_X);
    for (size_t i0 = gtid; i0 < (size_t)NTOK * DM / 8; i0 += 4 * gsz) {
        f32x4 a[4], b[4];
#pragma unroll
        for (int u = 0; u < 4; ++u) { const size_t i = i0 + u * gsz; const size_t e = (i < (size_t)NTOK * DM / 8 ? i : i0) * 8; const float* s = e < (size_t)NP * DM ? p.in(I_XP) + e : p.in(I_XS) + (e - (size_t)NP * DM);
            a[u] = *(const f32x4*)s; b[u] = *(const f32x4*)(s + 4); }
#pragma unroll
        for (int u = 0; u < 4; ++u) { const size_t i = i0 + u * gsz;
            if (i < (size_t)NTOK * DM / 8) { u32x4 w; w.x = cvt_pk_bf16(a[u][0], a[u][1]); w.y = cvt_pk_bf16(a[u][2], a[u][3]); w.z = cvt_pk_bf16(b[u][0], b[u][1]); w.w = cvt_pk_bf16(b[u][2], b[u][3]);
                *(u32x4*)(X + i * 8) = w; } } }
    float* rope = (float*)(p.ws() + WS_ROPE);
    for (size_t i = gtid; i < (size_t)2052 * 64; i += gsz) { const int pi = (int)(i >> 6), fi = (int)(i & 63);
        const double pos = pi < 2048 ? (double)pi : (double)(16384 + pi - 2048);
        const double ang = pos * INVF_TAB[fi];
        const double rr = ang - rint(ang * 0.15915494309189535) * 6.283185307179586;
        const float sn = __sinf((float)rr), cs = __cosf((float)rr);
        rope[(size_t)pi * 128 + fi] = cs; rope[(size_t)pi * 128 + 64 + fi] = sn; }
}

__device__ void phase_small(const DP& p, int l, LAS unsigned char* lds) {
    lds = launder_lds(lds);
    LAS float* wl = (LAS float*)lds;
    const int tid = my_tid(), lane = tid & 63, wave = tid >> 6, bid0 = my_bid();
    const float* win = p.in(I_WIN) + (size_t)l * 1024 * 9232;
    __syncthreads();
    {
#pragma unroll
        for (int i0 = 0; i0 < 32; i0 += 8) { float tmp[8];
#pragma unroll
            for (int i = 0; i < 8; ++i) { const int idx = tid + (i0 + i) * 512, k = idx >> 4, j = idx & 15; tmp[i] = win[(size_t)k * 9232 + (j < 8 ? 2048 + j : 6152 + (j - 8))]; }
#pragma unroll
            for (int i = 0; i < 8; ++i) { const int idx = tid + (i0 + i) * 512, k = idx >> 4, j = idx & 15; wl[j * 1024 + k] = tmp[i]; } } }
    __syncthreads();
    const bf16_t* X = (const bf16_t*)(p.ws() + WS_X); float* SM = (float*)(p.ws() + WS_SMALL);
    const int rstep = gridDim.x * 8; int r = bid0 * 8 + wave;
    u32x4 na = (u32x4){0u, 0u, 0u, 0u}, nb = na;
    if (r < NTOK) { na = *(const u32x4*)(X + (size_t)r * DM + lane * 16); nb = *(const u32x4*)(X + (size_t)r * DM + lane * 16 + 8); }
    for (; r < NTOK; r += rstep) {
        const u32x4 a = na, b = nb;
        if (r + rstep < NTOK) { na = *(const u32x4*)(X + (size_t)(r + rstep) * DM + lane * 16); nb = *(const u32x4*)(X + (size_t)(r + rstep) * DM + lane * 16 + 8); }
        float x[16] = {bflo(a.x), bfhi(a.x), bflo(a.y), bfhi(a.y), bflo(a.z), bfhi(a.z), bflo(a.w), bfhi(a.w), bflo(b.x), bfhi(b.x), bflo(b.y), bfhi(b.y), bflo(b.z), bfhi(b.z), bflo(b.w), bfhi(b.w)};
        float mine = 0.f;
#pragma unroll 1
        for (int jg = 0; jg < 4; ++jg) { float s4[4];
#pragma unroll
            for (int jj = 0; jj < 4; ++jj) { const int j = jg * 4 + jj; float acc = 0.f;
#pragma unroll
                for (int q = 0; q < 4; ++q) { const f32x4 w = *(const LAS f32x4*)(wl + j * 1024 + lane * 16 + q * 4); acc += x[q * 4] * w[0] + x[q * 4 + 1] * w[1] + x[q * 4 + 2] * w[2] + x[q * 4 + 3] * w[3]; }
                s4[jj] = acc; }
#pragma unroll
            for (int o = 32; o >= 1; o >>= 1) {
#pragma unroll
                for (int jj = 0; jj < 4; ++jj) s4[jj] += __shfl_xor(s4[jj], o); }
#pragma unroll
            for (int jj = 0; jj < 4; ++jj) if (lane == jg * 4 + jj) mine = s4[jj]; }
        if (lane < 16) SM[(size_t)r * 16 + lane] = mine;
    }
    __syncthreads();
}

__device__ __forceinline__ void ln_finish(const f32x4 (&v)[4], int r, int lane, const float* __restrict__ g, const float* __restrict__ bta, bf16_t* __restrict__ O, float* __restrict__ yp, float* __restrict__ ys) {
    float s = 0.f;
#pragma unroll
    for (int i = 0; i < 4; ++i) s += (v[i][0] + v[i][1]) + (v[i][2] + v[i][3]);
#pragma unroll
    for (int o = 32; o >= 1; o >>= 1) s += __shfl_xor(s, o);
    const float mu = s * (1.0f / 1024.0f); float q = 0.f;
#pragma unroll
    for (int i = 0; i < 4; ++i) { const f32x4 d = v[i] - mu; q += (d[0] * d[0] + d[1] * d[1]) + (d[2] * d[2] + d[3] * d[3]); }
#pragma unroll
    for (int o = 32; o >= 1; o >>= 1) q += __shfl_xor(q, o);
    const float rstd = rsqrtf(q * (1.0f / 1024.0f) + 1e-5f);
    float* y = yp ? (r < NP ? yp + (size_t)r * DM : ys + (size_t)(r - NP) * DM) : nullptr;
#pragma unroll
    for (int i = 0; i < 4; ++i) { const int c = i * 256 + lane * 4; const f32x4 gg = *(const f32x4*)(g + c), bb = *(const f32x4*)(bta + c);
        const f32x4 o = (v[i] - mu) * rstd * gg + bb;
        u32x2 w; w.x = cvt_pk_bf16(o[0], o[1]); w.y = cvt_pk_bf16(o[2], o[3]); *(u32x2*)(O + (size_t)r * DM + c) = w;
        if (y) *(f32x4*)(y + c) = o; }
}
__device__ void phase_ln(const bf16_t* __restrict__ T, const float* __restrict__ TS, int npieces, const float* __restrict__ g, const float* __restrict__ bta, bf16_t* __restrict__ O, float* __restrict__ yp, float* __restrict__ ys) {
    const int tid0 = my_tid(), lane = tid0 & 63, wave = tid0 >> 6, bid0 = my_bid();
    const int stride = gridDim.x * 8;
    const int nbf = npieces == 0 ? NTOK : NP;
    int r0 = bid0 * 8 + wave;
    for (; r0 + 3 * stride < nbf; r0 += 4 * stride) {
        u32x2 hh[4][4];
#pragma unroll
        for (int k = 0; k < 4; ++k)
#pragma unroll
            for (int i = 0; i < 4; ++i) hh[k][i] = *(const u32x2*)(T + (size_t)(r0 + k * stride) * DM + i * 256 + lane * 4);
#pragma unroll
        for (int k = 0; k < 4; ++k) { f32x4 vv[4];
#pragma unroll
            for (int i = 0; i < 4; ++i) vv[i] = (f32x4){bflo(hh[k][i].x), bfhi(hh[k][i].x), bflo(hh[k][i].y), bfhi(hh[k][i].y)};
            ln_finish(vv, r0 + k * stride, lane, g, bta, O, yp, ys); }
    }
    for (; r0 < nbf; r0 += stride) {
        f32x4 vv[4];
#pragma unroll
        for (int i = 0; i < 4; ++i) { const u32x2 h = *(const u32x2*)(T + (size_t)r0 * DM + i * 256 + lane * 4); vv[i] = (f32x4){bflo(h.x), bfhi(h.x), bflo(h.y), bfhi(h.y)}; }
        ln_finish(vv, r0, lane, g, bta, O, yp, ys);
    }
    if (npieces > 0) for (int r = NP + bid0 * 8 + wave; r < NTOK; r += stride) {
        f32x4 v[4]; const float* tp = TS + (size_t)(r - NP) * DM;
#pragma unroll
        for (int i = 0; i < 4; ++i) v[i] = *(const f32x4*)(tp + i * 256 + lane * 4);
        for (int z0 = 1; z0 < npieces; z0 += 4) { f32x4 tmp[4][4];
#pragma unroll
            for (int zz = 0; zz < 4; ++zz) { const int z = (z0 + zz < npieces) ? z0 + zz : z0;
#pragma unroll
                for (int i = 0; i < 4; ++i) tmp[zz][i] = *(const f32x4*)(tp + (size_t)z * (512 * 1024) + i * 256 + lane * 4); }
#pragma unroll
            for (int zz = 0; zz < 4; ++zz) if (z0 + zz < npieces) {
#pragma unroll
                for (int i = 0; i < 4; ++i) v[i] += tmp[zz][i]; } }
        ln_finish(v, r, lane, g, bta, O, yp, ys);
    }
}
template <int MIX  >
__device__ void rec_item(const DP& p, int l, bool prompt, int b, int h, LAS unsigned char* lds) {
    lds = launder_lds(lds);
    int tid_l = threadIdx.x; asm volatile("" : "+v"(tid_l));
    const int tid = tid_l, lane = tid & 63, wave = tid >> 6;
    const int v = tid & 127, kg = tid >> 7, k0 = kg * 32;
    const int T = prompt ? SEQ : 4, NBt = prompt ? NB : NDB;
    const size_t row0 = prompt ? (size_t)b * SEQ : (size_t)NP + (size_t)b * 4;
    const int pi0 = prompt ? 0 : 2048;
    bf16_t* PROJ = (bf16_t*)(p.ws() + WS_PROJ); const float* SM = (const float*)(p.ws() + WS_SMALL); const float* rope = (const float*)(p.ws() + WS_ROPE);
    LAS float* vec = (LAS float*)lds;
    LAS float* red = vec + 768;
    LAS float* part = red + 1024;
    LAS float* partS = part + 16;
    LAS float* partN = partS + 4;
    const size_t sidx = ((size_t)(l * NBt + b) * 4 + h);
    float S[32];
    {
        const float* st_in = prompt ? nullptr : p.in(MIX == 0 ? I_SS : (MIX == 1 ? I_SR : I_SC)) + sidx * 16384;
#pragma unroll
        for (int i = 0; i < 32; ++i) S[i] = st_in ? st_in[(k0 + i) * 128 + v] : 0.f;
    }
    float nn = 0.f, mm = 0.f;
    if (MIX == 2 && !prompt) { if (tid < 128) nn = p.in(I_SN)[sidx * 128 + tid]; mm = p.in(I_SM)[sidx]; }
    const int which = tid >> 7, cc = tid & 127;
    const int colq = MIX * 2048 + h * 128, colg = colq + 1536;
    const int gcol = which * 512 + h * 128 + cc;
    float cw0 = 0.f, cw1 = 0.f, cw2 = 0.f, cw3 = 0.f, x0 = 0.f, x1 = 0.f, x2 = 0.f;
    if (MIX == 0 && tid < 384) {
        const float* cwp = p.in(I_CONVW) + (size_t)l * 4 * 1536 + gcol; cw0 = cwp[0]; cw1 = cwp[1536]; cw2 = cwp[2 * 1536]; cw3 = cwp[3 * 1536];
        if (!prompt) { const float* cb = p.in(I_SCONV) + (size_t)(l * NDB + b) * 3 * 1536 + gcol; x0 = cb[0]; x1 = cb[1536]; x2 = cb[2 * 1536]; }
    }
    float Aexp = 0.f, dtb = 0.f, normw = 1.f, gamma = 0.f, ib = 0.f, fb = 0.f;
    if (MIX == 0) { Aexp = __expf(p.in(I_ALOG)[l * 4 + h]); dtb = p.in(I_DTB)[l * 4 + h]; normw = p.in(I_DNW)[l * 128 + v]; }
    if (MIX == 1) gamma = 1.0f - exp2f(-5.0f - (float)h);
    if (MIX == 2) { ib = p.in(I_IB)[l * 4 + h]; fb = p.in(I_FB)[l * 4 + h]; normw = p.in(I_MLW)[l * 512 + h * 128 + v]; }
    bf16_t pa = 0, pb = 0, pg = 0; float s0 = 0.f, s1 = 0.f;
#define REC_PREFETCH(tt) do { const size_t r_ = row0 + (tt); const bf16_t* pr = PROJ + r_ * PW; \
        if (tid < 384) { \
            if (MIX == 0) pa = pr[gcol]; \
            else if (MIX == 1 && which < 2) { const int i_ = cc & 63; pa = pr[colq + which * 512 + i_]; pb = pr[colq + which * 512 + i_ + 64]; } \
            else pa = pr[colq + which * 512 + cc]; \
        } \
        if (tid < 128) pg = pr[colg + v]; \
        if (MIX == 0) { s0 = SM[r_ * 16 + h]; s1 = SM[r_ * 16 + 4 + h]; } \
        if (MIX == 2) { s0 = SM[r_ * 16 + 8 + h]; s1 = SM[r_ * 16 + 12 + h]; } } while (0)
    REC_PREFETCH(0);
    __syncthreads();
    for (int t = 0; t < T; ++t) {
        const int par = t & 1; const size_t r = row0 + t;
        const bf16_t ca = pa, cb = pb, cgate = pg; const float cs0 = s0, cs1 = s1;
        if (t + 1 < T) REC_PREFETCH(t + 1);
        if (tid < 384) {
            float val;
            if (MIX == 0) { const float xn = bf2f(ca); const float c = x0 * cw0 + x1 * cw1 + x2 * cw2 + xn * cw3; x0 = x1; x1 = x2; x2 = xn; val = siluf_(c);
                if (which < 2) { float q = val * val;
#pragma unroll
                    for (int o = 32; o >= 1; o >>= 1) q += __shfl_xor(q, o);
                    if (lane == 0) part[par * 8 + wave] = q; } }
            else if (MIX == 1 && which < 2) { const int i = cc & 63; const float xa = bf2f(ca), xb = bf2f(cb); const float cs = rope[(size_t)(pi0 + t) * 128 + i], sn = rope[(size_t)(pi0 + t) * 128 + 64 + i];
                val = cc < 64 ? xa * cs - xb * sn : xa * sn + xb * cs; if (which == 1) val *= DKS; }
            else { val = bf2f(ca); if (MIX != 0 && which == 1) val *= DKS; }
            vec[par * 384 + which * 128 + cc] = val;
        }
        __syncthreads();
        float a = 1.f, qs = 1.f, ks = 1.f, beta = 0.f, ipr = 1.f;
        if (MIX == 0) { beta = sigmoidf_(cs0); const float g = -Aexp * softplusf_(cs1 + dtb); a = __expf(g);
            qs = rsqrtf(part[par * 8 + 0] + part[par * 8 + 1] + 1e-6f) * DKS; ks = rsqrtf(part[par * 8 + 2] + part[par * 8 + 3] + 1e-6f); }
        if (MIX == 1) a = gamma;
        if (MIX == 2) { const float ip = cs0 + ib, fp = cs1 + fb; const float lf = logsigmoidf_(fp); const float mnew = fmaxf(lf + mm, ip); a = __expf(lf + mm - mnew); ipr = __expf(ip - mnew); mm = mnew; }
        const float vv = vec[par * 384 + 256 + v];
        float vnew;
        if (MIX == 0) { float pk = 0.f;
#pragma unroll
            for (int i = 0; i < 32; ++i) pk += vec[par * 384 + 128 + k0 + i] * S[i];
            red[kg * 128 + v] = pk * ks;
            __syncthreads();
            const float kS = (red[v] + red[128 + v]) + (red[256 + v] + red[384 + v]);
            vnew = beta * (vv - a * kS); }
        else if (MIX == 1) vnew = vv;
        else vnew = ipr * vv;
        float po = 0.f;
#pragma unroll
        for (int i = 0; i < 32; ++i) { S[i] = a * S[i] + (vec[par * 384 + 128 + k0 + i] * ks) * vnew; po += vec[par * 384 + k0 + i] * S[i]; }
        red[512 + kg * 128 + v] = po * qs;
        if (MIX == 2 && tid < 128) { nn = a * nn + ipr * vec[par * 384 + 128 + tid]; float qn = vec[par * 384 + tid] * nn;
#pragma unroll
            for (int o = 32; o >= 1; o >>= 1) qn += __shfl_xor(qn, o);
            if (lane == 0) partN[par * 2 + wave] = qn; }
        __syncthreads();
        float o = 0.f;
        if (tid < 128) { o = (red[512 + v] + red[512 + 128 + v]) + (red[512 + 256 + v] + red[512 + 384 + v]); float q = o * o;
#pragma unroll
            for (int of = 32; of >= 1; of >>= 1) q += __shfl_xor(q, of);
            if (lane == 0) partS[par * 2 + wave] = q; }
        __syncthreads();
        if (tid < 128) {
            const float ssq = partS[par * 2] + partS[par * 2 + 1]; const float gt = bf2f(cgate); float out;
            if (MIX == 2) { const float den = partN[par * 2] + partN[par * 2 + 1]; const float dd = fmaxf(fabsf(den), __expf(-mm)); const float hv = o / dd;
                out = hv * rsqrtf(ssq / (dd * dd) * (1.0f / 128.0f) + 1e-6f) * normw * sigmoidf_(gt); }
            else out = o * rsqrtf(ssq * (1.0f / 128.0f) + 1e-6f) * normw * siluf_(gt);
            PROJ[r * PW + colg + v] = f2bf(out);
        }
    }
    float* outp = p.out();
    {
        float* so = outp + (prompt ? (MIX == 0 ? O_PS : (MIX == 1 ? O_PR : O_PC)) : (MIX == 0 ? O_SS : (MIX == 1 ? O_SR : O_SC))) + sidx * 16384;
#pragma unroll
        for (int i = 0; i < 32; ++i) so[(k0 + i) * 128 + v] = S[i];
    }
    if (MIX == 0 && tid < 384) { float* co = outp + (prompt ? O_PCONV : O_SCONV) + (size_t)(l * NBt + b) * 3 * 1536 + gcol; co[0] = x0; co[1536] = x1; co[2 * 1536] = x2; }
    if (MIX == 2) { if (tid < 128) outp[(prompt ? O_PN : O_SN) + sidx * 128 + tid] = nn; if (tid == 0) outp[(prompt ? O_PM : O_SM) + sidx] = mm; }
    __syncthreads();
}
__device__ __forceinline__ bf16x8 ldfrag(const LAS bf16_t* base, int row, int ld, int k) { return *(const LAS bf16x8*)(base + row * ld + k); }
#define MFMA16(a, b, c) __builtin_amdgcn_mfma_f32_16x16x32_bf16((a), (b), (c), 0, 0, 0)

template <int MIX  >
__device__ void scan_item(const DP& p, int l, int b, int h, LAS unsigned char* lds) {
    lds = launder_lds(lds);
    const int tid = my_tid(), lane = tid & 63, wave = __builtin_amdgcn_readfirstlane(tid >> 6), l16 = lane & 15, quad = lane >> 4;
    bf16_t* PROJ = (bf16_t*)(p.ws() + WS_PROJ); const float* SM = (const float*)(p.ws() + WS_SMALL); const float* rope = (const float*)(p.ws() + WS_ROPE);
    LAS bf16_t* Qs = (LAS bf16_t*)(lds + 0); LAS bf16_t* Ks = (LAS bf16_t*)(lds + 17408); LAS bf16_t* KdT = (LAS bf16_t*)(lds + 34816);
    LAS bf16_t* VT = (LAS bf16_t*)(lds + 53248); LAS bf16_t* Ps = (LAS bf16_t*)(lds + 71680); LAS bf16_t* RT = (LAS bf16_t*)(lds + 80896);
    LAS float* red = (LAS float*)(lds + 115712); LAS float* GT = (LAS float*)(lds + 116224); LAS float* sdecs = (LAS float*)(lds + 118784);
    LAS float* nm = (LAS float*)(lds + 118800); LAS float* denl = (LAS float*)(lds + 119312);
    const int colq = MIX * 2048 + h * 128;
    const size_t row0 = (size_t)b * SEQ;
    const size_t sidx = (size_t)(l * NB + b) * 4 + h;
    __syncthreads();
    for (int i = tid; i < 128 * 136 / 2; i += 512) ((LAS unsigned*)RT)[i] = 0u;
    if (tid < 128) nm[tid] = 0.f;
    if (MIX == 1 && tid < 64) { const float lng = logf(1.0f - exp2f(-5.0f - (float)h));
#pragma unroll
        for (int par = 0; par < 2; ++par) { LAS float* G_ = GT + par * 320; G_[tid] = (float)tid * lng; G_[64 + tid] = -(float)tid * lng; G_[128 + tid] = __expf((float)(tid + 1) * lng); G_[192 + tid] = __expf((float)(63 - tid) * lng); G_[256 + tid] = 0.f; }
        if (tid == 0) { sdecs[0] = __expf(64.0f * lng); sdecs[1] = sdecs[0]; } }
    f32x4 Racc[8];
#pragma unroll
    for (int i = 0; i < 8; ++i) Racc[i] = (f32x4){0.f, 0.f, 0.f, 0.f};
    float mm = 0.f;
    const float ib = MIX == 2 ? p.in(I_IB)[l * 4 + h] : 0.f, fb = MIX == 2 ? p.in(I_FB)[l * 4 + h] : 0.f;
    const int lrow = tid & 63, cg = tid >> 6;
    u32x4 q1, q2, k1, k2, v1, v2; f32x4 rc0, rc1, rs0, rs1; float ipre = 0.f, fpre = 0.f; u32x2 gpre[4];
#define SC_LOAD(n_) do { const bf16_t* pr = PROJ + (row0 + (size_t)(n_) * 64 + lrow) * PW + colq; \
        q1 = *(const u32x4*)(pr + cg * 8); q2 = *(const u32x4*)(pr + 64 + cg * 8); k1 = *(const u32x4*)(pr + 512 + cg * 8); k2 = *(const u32x4*)(pr + 512 + 64 + cg * 8); \
        v1 = *(const u32x4*)(pr + 1024 + cg * 16); v2 = *(const u32x4*)(pr + 1024 + cg * 16 + 8); \
        if (MIX == 1) { const float* rp = rope + (size_t)((n_) * 64 + lrow) * 128 + cg * 8; rc0 = *(const f32x4*)rp; rc1 = *(const f32x4*)(rp + 4); rs0 = *(const f32x4*)(rp + 64); rs1 = *(const f32x4*)(rp + 68); } \
        if (MIX == 2 && wave == 0) { const size_t r_ = row0 + (size_t)(n_) * 64 + lane; ipre = SM[r_ * 16 + 8 + h]; fpre = SM[r_ * 16 + 12 + h]; } } while (0)
#define SC_GATES(n_) do { const float ip = ipre + ib, fp = fpre + fb; \
        float F = logsigmoidf_(fp); \
        _Pragma("unroll") for (int d = 1; d < 64; d <<= 1) { const float y = __shfl_up(F, d); if (lane >= d) F += y; } \
        const float a_ = ip - F; float cm = a_; \
        _Pragma("unroll") for (int d = 1; d < 64; d <<= 1) { const float y = __shfl_up(cm, d); if (lane >= d) cm = fmaxf(cm, y); } \
        const float mt = fmaxf(mm + F, F + cm); const float wst = __expf(mm + F - mt); \
        const float mnew = __shfl(mt, 63), Fl = __shfl(F, 63); \
        LAS float* G_ = GT + ((n_) & 1) * 320; G_[lane] = F - mt; G_[64 + lane] = a_; G_[128 + lane] = wst; G_[192 + lane] = __expf(a_ + Fl - mnew); G_[256 + lane] = __expf(-mt); \
        if (lane == 0) sdecs[(n_) & 1] = __expf(mm + Fl - mnew); mm = mnew; } while (0)
#define SC_STORE(n_) do { const int t_ = lrow; \
        float qa[8], qb[8], ka[8], kb[8]; \
        { const unsigned qw1[4] = {q1.x, q1.y, q1.z, q1.w}, qw2[4] = {q2.x, q2.y, q2.z, q2.w}, kw1[4] = {k1.x, k1.y, k1.z, k1.w}, kw2[4] = {k2.x, k2.y, k2.z, k2.w}; \
          _Pragma("unroll") for (int e = 0; e < 4; ++e) { qa[2 * e] = bflo(qw1[e]); qa[2 * e + 1] = bfhi(qw1[e]); qb[2 * e] = bflo(qw2[e]); qb[2 * e + 1] = bfhi(qw2[e]); \
              ka[2 * e] = bflo(kw1[e]); ka[2 * e + 1] = bfhi(kw1[e]); kb[2 * e] = bflo(kw2[e]); kb[2 * e + 1] = bfhi(kw2[e]); } } \
        float kdec; \
        if (MIX == 1) { const f32x4 c0 = rc0, c1 = rc1, s0 = rs0, s1 = rs1; \
            const float cs[8] = {c0[0], c0[1], c0[2], c0[3], c1[0], c1[1], c1[2], c1[3]}, sn[8] = {s0[0], s0[1], s0[2], s0[3], s1[0], s1[1], s1[2], s1[3]}; \
            _Pragma("unroll") for (int e = 0; e < 8; ++e) { const float x1 = qa[e], x2 = qb[e]; qa[e] = x1 * cs[e] - x2 * sn[e]; qb[e] = x1 * sn[e] + x2 * cs[e]; \
                const float y1 = ka[e], y2 = kb[e]; ka[e] = y1 * cs[e] - y2 * sn[e]; kb[e] = y1 * sn[e] + y2 * cs[e]; } \
            } \
        kdec = GT[((n_) & 1) * 320 + 192 + t_]; \
        _Pragma("unroll") for (int e = 0; e < 8; ++e) { ka[e] *= DKS; kb[e] *= DKS; } \
        { u32x4 w; w.x = cvt_pk_bf16(qa[0], qa[1]); w.y = cvt_pk_bf16(qa[2], qa[3]); w.z = cvt_pk_bf16(qa[4], qa[5]); w.w = cvt_pk_bf16(qa[6], qa[7]); *(LAS u32x4*)(Qs + t_ * 136 + cg * 8) = w; \
          w.x = cvt_pk_bf16(qb[0], qb[1]); w.y = cvt_pk_bf16(qb[2], qb[3]); w.z = cvt_pk_bf16(qb[4], qb[5]); w.w = cvt_pk_bf16(qb[6], qb[7]); *(LAS u32x4*)(Qs + t_ * 136 + 64 + cg * 8) = w; \
          w.x = cvt_pk_bf16(ka[0], ka[1]); w.y = cvt_pk_bf16(ka[2], ka[3]); w.z = cvt_pk_bf16(ka[4], ka[5]); w.w = cvt_pk_bf16(ka[6], ka[7]); *(LAS u32x4*)(Ks + t_ * 136 + cg * 8) = w; \
          w.x = cvt_pk_bf16(kb[0], kb[1]); w.y = cvt_pk_bf16(kb[2], kb[3]); w.z = cvt_pk_bf16(kb[4], kb[5]); w.w = cvt_pk_bf16(kb[6], kb[7]); *(LAS u32x4*)(Ks + t_ * 136 + 64 + cg * 8) = w; } \
        _Pragma("unroll") for (int e = 0; e < 8; ++e) { KdT[(cg * 8 + e) * 72 + t_] = f2bf(ka[e] * kdec); KdT[(64 + cg * 8 + e) * 72 + t_] = f2bf(kb[e] * kdec); } \
        { const unsigned vw[8] = {v1.x, v1.y, v1.z, v1.w, v2.x, v2.y, v2.z, v2.w}; \
          _Pragma("unroll") for (int e = 0; e < 8; ++e) { VT[(cg * 16 + 2 * e) * 72 + t_] = (bf16_t)(vw[e] & 0xffffu); VT[(cg * 16 + 2 * e + 1) * 72 + t_] = (bf16_t)(vw[e] >> 16); } } } while (0)

    SC_LOAD(0);
    if (MIX == 2 && wave == 0) SC_GATES(0);
    __syncthreads();
    SC_STORE(0);
    const int tm = wave >> 1, tnb = (wave & 1) * 2, tnb4 = (wave & 1) * 4;
    f32x4 nwv[4];
#pragma unroll
    for (int i = 0; i < 4; ++i) nwv[i] = MIX == 2 ? *(const f32x4*)(p.in(I_MLW) + l * 512 + h * 128 + 16 * (tnb4 + i) + 4 * quad) : (f32x4){1.f, 1.f, 1.f, 1.f};
    const int t = 16 * tm + l16;
    for (int n = 0; n < 32; ++n) {
        __syncthreads();
        if (n + 1 < 32) SC_LOAD(n + 1);
        { const bf16_t* gp_ = PROJ + (row0 + (size_t)n * 64 + t) * PW + colq + 1536;
#pragma unroll
          for (int i = 0; i < 4; ++i) gpre[i] = *(const u32x2*)(gp_ + 16 * (tnb4 + i) + 4 * quad); }
        const LAS float* G = GT + (n & 1) * 320;
        {
            f32x4 pacc[2] = {(f32x4){0.f, 0.f, 0.f, 0.f}, (f32x4){0.f, 0.f, 0.f, 0.f}};
#pragma unroll
            for (int kk = 0; kk < 4; ++kk) { const bf16x8 a = ldfrag(Qs, t, 136, kk * 32 + quad * 8);
#pragma unroll
                for (int i = 0; i < 2; ++i) { const bf16x8 bq = ldfrag(Ks, 16 * (tnb + i) + l16, 136, kk * 32 + quad * 8); pacc[i] = MFMA16(bq, a, pacc[i]); } }
            const float gt_ = G[t];
#pragma unroll
            for (int i = 0; i < 2; ++i) { const int s0 = 16 * (tnb + i) + 4 * quad; float w[4]; const f32x4 ga = *(const LAS f32x4*)(G + 64 + s0);
#pragma unroll
                for (int j = 0; j < 4; ++j) { const int s = s0 + j; float f;
                    f = __expf(gt_ + ga[j]);
                    w[j] = s <= t ? pacc[i][j] * f : 0.f; }
                u32x2 o; o.x = cvt_pk_bf16(w[0], w[1]); o.y = cvt_pk_bf16(w[2], w[3]); *(LAS u32x2*)(Ps + t * 72 + s0) = o; }
        }
        __syncthreads();
        f32x4 o2[4];
        {
            f32x4 o1[4];
#pragma unroll
            for (int i = 0; i < 4; ++i) { o1[i] = (f32x4){0.f, 0.f, 0.f, 0.f}; o2[i] = (f32x4){0.f, 0.f, 0.f, 0.f}; }
#pragma unroll
            for (int kk = 0; kk < 4; ++kk) { const bf16x8 a = ldfrag(Qs, t, 136, kk * 32 + quad * 8);
#pragma unroll
                for (int i = 0; i < 4; ++i) { const bf16x8 bq = ldfrag(RT, 16 * (tnb4 + i) + l16, 136, kk * 32 + quad * 8); o1[i] = MFMA16(bq, a, o1[i]); } }
#pragma unroll
            for (int kk = 0; kk < 2; ++kk) { const bf16x8 a = ldfrag(Ps, t, 72, kk * 32 + quad * 8);
#pragma unroll
                for (int i = 0; i < 4; ++i) { const bf16x8 bq = ldfrag(VT, 16 * (tnb4 + i) + l16, 72, kk * 32 + quad * 8); o2[i] = MFMA16(bq, a, o2[i]); } }
            const float qd = G[128 + t];
            float ssq = 0.f;
#pragma unroll
            for (int i = 0; i < 4; ++i) { o2[i] = o1[i] * qd + o2[i]; ssq += (o2[i][0] * o2[i][0] + o2[i][1] * o2[i][1]) + (o2[i][2] * o2[i][2] + o2[i][3] * o2[i][3]); }
            ssq += __shfl_xor(ssq, 16); ssq += __shfl_xor(ssq, 32);
            if (quad == 0) red[t * 2 + (wave & 1)] = ssq;
        }
        float nnew = 0.f;
        if (MIX == 2) {
            { const int tp = tid >> 3, part = tid & 7; float qn = 0.f, ds = 0.f;
              const u32x4 qa_ = *(const LAS u32x4*)(Qs + tp * 136 + part * 16), qb_ = *(const LAS u32x4*)(Qs + tp * 136 + part * 16 + 8), pp_ = *(const LAS u32x4*)(Ps + tp * 72 + part * 8);
              const f32x4 n0 = *(const LAS f32x4*)(nm + part * 16), n1 = *(const LAS f32x4*)(nm + part * 16 + 4), n2 = *(const LAS f32x4*)(nm + part * 16 + 8), n3 = *(const LAS f32x4*)(nm + part * 16 + 12);
              qn = (bflo(qa_.x) * n0[0] + bfhi(qa_.x) * n0[1]) + (bflo(qa_.y) * n0[2] + bfhi(qa_.y) * n0[3]) + (bflo(qa_.z) * n1[0] + bfhi(qa_.z) * n1[1]) + (bflo(qa_.w) * n1[2] + bfhi(qa_.w) * n1[3])
                 + (bflo(qb_.x) * n2[0] + bfhi(qb_.x) * n2[1]) + (bflo(qb_.y) * n2[2] + bfhi(qb_.y) * n2[3]) + (bflo(qb_.z) * n3[0] + bfhi(qb_.z) * n3[1]) + (bflo(qb_.w) * n3[2] + bfhi(qb_.w) * n3[3]);
              ds = (bflo(pp_.x) + bfhi(pp_.x)) + (bflo(pp_.y) + bfhi(pp_.y)) + (bflo(pp_.z) + bfhi(pp_.z)) + (bflo(pp_.w) + bfhi(pp_.w));
              qn += __shfl_xor(qn, 1); qn += __shfl_xor(qn, 2); qn += __shfl_xor(qn, 4); ds += __shfl_xor(ds, 1); ds += __shfl_xor(ds, 2); ds += __shfl_xor(ds, 4);
              if (part == 0) denl[tp] = G[128 + tp] * qn + ds; }
            { const int kp = tid >> 2, pp = tid & 3;
              const u32x4 ka_ = *(const LAS u32x4*)(KdT + kp * 72 + pp * 16), kb_ = *(const LAS u32x4*)(KdT + kp * 72 + pp * 16 + 8);
              float sm = ((bflo(ka_.x) + bfhi(ka_.x)) + (bflo(ka_.y) + bfhi(ka_.y))) + ((bflo(ka_.z) + bfhi(ka_.z)) + (bflo(ka_.w) + bfhi(ka_.w)))
                       + ((bflo(kb_.x) + bfhi(kb_.x)) + (bflo(kb_.y) + bfhi(kb_.y))) + ((bflo(kb_.z) + bfhi(kb_.z)) + (bflo(kb_.w) + bfhi(kb_.w)));
              sm += __shfl_xor(sm, 1); sm += __shfl_xor(sm, 2);
              nnew = sdecs[n & 1] * nm[kp] + sm; }
        }
        {
            const float cdec = sdecs[n & 1];
#pragma unroll
            for (int tn = 0; tn < 8; ++tn) Racc[tn] = Racc[tn] * cdec;
#pragma unroll
            for (int kk = 0; kk < 2; ++kk) { const bf16x8 a = ldfrag(KdT, 16 * wave + l16, 72, kk * 32 + quad * 8);
#pragma unroll
                for (int tn = 0; tn < 8; ++tn) { const bf16x8 bq = ldfrag(VT, 16 * tn + l16, 72, kk * 32 + quad * 8); Racc[tn] = MFMA16(a, bq, Racc[tn]); } }
        }
        if (MIX == 2 && wave == 0 && n + 1 < 32) SC_GATES(n + 1);
        __syncthreads();
#pragma unroll
        for (int tn = 0; tn < 8; ++tn) { u32x2 o; o.x = cvt_pk_bf16(Racc[tn][0], Racc[tn][1]); o.y = cvt_pk_bf16(Racc[tn][2], Racc[tn][3]); *(LAS u32x2*)(RT + (16 * tn + l16) * 136 + 16 * wave + 4 * quad) = o; }
        if (MIX == 2 && (tid & 3) == 0) nm[tid >> 2] = nnew;
        {
            const float ssqt = red[t * 2] + red[t * 2 + 1]; float rs;
            if (MIX == 1) rs = rsqrtf(ssqt * (1.0f / 128.0f) + 1e-6f);
            else { const float dd = fmaxf(fabsf(denl[t]), G[256 + t]); const float inv = 1.0f / dd; rs = inv * rsqrtf(ssqt * inv * inv * (1.0f / 128.0f) + 1e-6f); }
            bf16_t* gp = PROJ + (row0 + (size_t)n * 64 + t) * PW + colq + 1536;
#pragma unroll
            for (int i = 0; i < 4; ++i) { const int c0 = 16 * (tnb4 + i) + 4 * quad; const u32x2 gv = gpre[i]; float g4[4] = {bflo(gv.x), bfhi(gv.x), bflo(gv.y), bfhi(gv.y)}, r4[4];
                if (MIX == 1) {
#pragma unroll
                    for (int j = 0; j < 4; ++j) r4[j] = o2[i][j] * rs * siluf_(g4[j]); }
                else { const f32x4 nw = nwv[i];
#pragma unroll
                    for (int j = 0; j < 4; ++j) r4[j] = o2[i][j] * rs * nw[j] * sigmoidf_(g4[j]); }
                u32x2 ov; ov.x = cvt_pk_bf16(r4[0], r4[1]); ov.y = cvt_pk_bf16(r4[2], r4[3]); *(u32x2*)(gp + c0) = ov; }
        }
        if (n + 1 < 32) SC_STORE(n + 1);
    }
    {
        float* so = p.out() + (MIX == 1 ? O_PR : O_PC) + sidx * 16384;
#pragma unroll
        for (int tn = 0; tn < 8; ++tn)
#pragma unroll
            for (int j = 0; j < 4; ++j) so[(16 * wave + 4 * quad + j) * 128 + 16 * tn + l16] = Racc[tn][j];
    }
    __syncthreads();
    if (MIX == 2) { if (tid < 128) p.out()[O_PN + sidx * 128 + tid] = nm[tid]; if (tid == 0) p.out()[O_PM + sidx] = mm; }
    __syncthreads();
#undef SC_LOAD
#undef SC_GATES
#undef SC_STORE
}
__device__ void dn_prep_item(const DP& p, int l, int b, int n, int h, LAS unsigned char* lds) {
    lds = launder_lds(lds);
    const int tid = my_tid(), lane = tid & 63, wave = __builtin_amdgcn_readfirstlane(tid >> 6), l16 = lane & 15, quad = lane >> 4;
    const bf16_t* PROJ = (const bf16_t*)(p.ws() + WS_PROJ); const float* SM = (const float*)(p.ws() + WS_SMALL);
    LAS bf16_t* Kn = (LAS bf16_t*)(lds + 0); LAS bf16_t* Qn = (LAS bf16_t*)(lds + 17408); LAS float* MT = (LAS float*)(lds + 34816);
    LAS float* Vf = (LAS float*)(lds + 52224); LAS float* Kf = (LAS float*)(lds + 84992);
    LAS float* gcs = (LAS float*)(lds + 117760); LAS float* betas = gcs + 64; LAS float* egs = gcs + 128;
    LAS bf16_t* MB = (LAS bf16_t*)(lds + 118528);
    LAS bf16_t* XT = (LAS bf16_t*)(lds + 0);
    const size_t row0 = (size_t)b * SEQ + (size_t)n * 64;
    const int ci = (b * 4 + h) * 32 + n;
    unsigned char* aux = p.ws() + WS_AUX;
    __syncthreads();
    LAS float* cwl = MT;
    if (tid < 384) { const int wh_ = tid >> 7, cc_ = tid & 127; const float* cwp = p.in(I_CONVW) + (size_t)l * 4 * 1536 + wh_ * 512 + h * 128 + cc_;
#pragma unroll
        for (int j = 0; j < 4; ++j) cwl[(wh_ * 4 + j) * 128 + cc_] = cwp[j * 1536]; }
    if (wave == 0) {
        const size_t r = row0 + lane; const float beta = sigmoidf_(SM[r * 16 + h]);
        float gc = -__expf(p.in(I_ALOG)[l * 4 + h]) * softplusf_(SM[r * 16 + 4 + h] + p.in(I_DTB)[l * 4 + h]);
#pragma unroll
        for (int d = 1; d < 64; d <<= 1) { const float y = __shfl_up(gc, d); if (lane >= d) gc += y; }
        gcs[lane] = gc; betas[lane] = beta; egs[lane] = __expf(gc);
        if (lane == 63) ((float*)(aux + AUX_EG))[ci] = __expf(gc);
    }
    __syncthreads();
    const int t = tid >> 3, cg = tid & 7;
    float qv[16];
#pragma unroll
    for (int which = 0; which < 3; ++which) {
        const int gcol = which * 512 + h * 128 + cg * 16;
        float acc[16], xs[16];
#pragma unroll
        for (int e = 0; e < 16; ++e) { acc[e] = 0.f; xs[e] = 0.f; }
        u32x4 xa[4], xb[4];
#pragma unroll
        for (int j = 0; j < 4; ++j) { const int tok = n * 64 + t + j - 3; const int tokc = tok < 0 ? 0 : tok;
            const bf16_t* xp = PROJ + ((size_t)b * SEQ + tokc) * PW + gcol; xa[j] = *(const u32x4*)xp; xb[j] = *(const u32x4*)(xp + 8); }
#pragma unroll
        for (int j = 0; j < 4; ++j) { const int tok = n * 64 + t + j - 3; const float msk = tok >= 0 ? 1.0f : 0.0f;
            const LAS float* wp = cwl + (which * 4 + j) * 128 + cg * 16;
            const f32x4 w0 = *(const LAS f32x4*)wp, w1 = *(const LAS f32x4*)(wp + 4), w2 = *(const LAS f32x4*)(wp + 8), w3 = *(const LAS f32x4*)(wp + 12);
            const float xf[16] = {bflo(xa[j].x), bfhi(xa[j].x), bflo(xa[j].y), bfhi(xa[j].y), bflo(xa[j].z), bfhi(xa[j].z), bflo(xa[j].w), bfhi(xa[j].w), bflo(xb[j].x), bfhi(xb[j].x), bflo(xb[j].y), bfhi(xb[j].y), bflo(xb[j].z), bfhi(xb[j].z), bflo(xb[j].w), bfhi(xb[j].w)};
            const float wf[16] = {w0[0], w0[1], w0[2], w0[3], w1[0], w1[1], w1[2], w1[3], w2[0], w2[1], w2[2], w2[3], w3[0], w3[1], w3[2], w3[3]};
#pragma unroll
            for (int e = 0; e < 16; ++e) { acc[e] += xf[e] * (wf[e] * msk); if (j == 3) xs[e] = xf[e]; }
        }
        if (n == 31 && t >= 61) { float* co = p.out() + O_PCONV + ((size_t)(l * NB + b) * 3 + (t - 61)) * 1536 + gcol;
#pragma unroll
            for (int e = 0; e < 16; ++e) co[e] = xs[e]; }
        float ssq = 0.f;
#pragma unroll
        for (int e = 0; e < 16; ++e) { acc[e] = siluf_(acc[e]); ssq += acc[e] * acc[e]; }
        if (which < 2) { ssq += __shfl_xor(ssq, 1); ssq += __shfl_xor(ssq, 2); ssq += __shfl_xor(ssq, 4);
            const float sc = rsqrtf(ssq + 1e-6f) * (which == 0 ? DKS : 1.0f);
#pragma unroll
            for (int e = 0; e < 16; ++e) acc[e] *= sc; }
        if (which == 0) {
#pragma unroll
            for (int e = 0; e < 16; ++e) qv[e] = acc[e];
            u32x4 w; w.x = cvt_pk_bf16(acc[0], acc[1]); w.y = cvt_pk_bf16(acc[2], acc[3]); w.z = cvt_pk_bf16(acc[4], acc[5]); w.w = cvt_pk_bf16(acc[6], acc[7]); *(LAS u32x4*)(Qn + t * 136 + cg * 16) = w;
            w.x = cvt_pk_bf16(acc[8], acc[9]); w.y = cvt_pk_bf16(acc[10], acc[11]); w.z = cvt_pk_bf16(acc[12], acc[13]); w.w = cvt_pk_bf16(acc[14], acc[15]); *(LAS u32x4*)(Qn + t * 136 + cg * 16 + 8) = w;
        } else if (which == 1) {
            u32x4 w; w.x = cvt_pk_bf16(acc[0], acc[1]); w.y = cvt_pk_bf16(acc[2], acc[3]); w.z = cvt_pk_bf16(acc[4], acc[5]); w.w = cvt_pk_bf16(acc[6], acc[7]); *(LAS u32x4*)(Kn + t * 136 + cg * 16) = w;
            w.x = cvt_pk_bf16(acc[8], acc[9]); w.y = cvt_pk_bf16(acc[10], acc[11]); w.z = cvt_pk_bf16(acc[12], acc[13]); w.w = cvt_pk_bf16(acc[14], acc[15]); *(LAS u32x4*)(Kn + t * 136 + cg * 16 + 8) = w;
#pragma unroll
            for (int q4 = 0; q4 < 4; ++q4) *(LAS f32x4*)(Kf + t * 128 + cg * 16 + q4 * 4) = (f32x4){acc[q4 * 4], acc[q4 * 4 + 1], acc[q4 * 4 + 2], acc[q4 * 4 + 3]};
        } else {
#pragma unroll
            for (int q4 = 0; q4 < 4; ++q4) *(LAS f32x4*)(Vf + t * 128 + cg * 16 + q4 * 4) = (f32x4){acc[q4 * 4], acc[q4 * 4 + 1], acc[q4 * 4 + 2], acc[q4 * 4 + 3]};
        }
    }
    __syncthreads();
    { const float eg = egs[t]; bf16_t* o = (bf16_t*)(aux + AUX_QG) + (size_t)ci * 8192 + t * 128 + cg * 16;
      u32x4 w; w.x = cvt_pk_bf16(qv[0] * eg, qv[1] * eg); w.y = cvt_pk_bf16(qv[2] * eg, qv[3] * eg); w.z = cvt_pk_bf16(qv[4] * eg, qv[5] * eg); w.w = cvt_pk_bf16(qv[6] * eg, qv[7] * eg); *(u32x4*)o = w;
      w.x = cvt_pk_bf16(qv[8] * eg, qv[9] * eg); w.y = cvt_pk_bf16(qv[10] * eg, qv[11] * eg); w.z = cvt_pk_bf16(qv[12] * eg, qv[13] * eg); w.w = cvt_pk_bf16(qv[14] * eg, qv[15] * eg); *(u32x4*)(o + 8) = w; }
    { const int k = tid >> 2, sq = tid & 3; const float gl = gcs[63]; float vals[16];
#pragma unroll
      for (int e = 0; e < 16; ++e) { const int s = sq * 16 + e; vals[e] = Kf[s * 128 + k] * __expf(gl - gcs[s]); }
      bf16_t* o = (bf16_t*)(aux + AUX_KDT) + (size_t)ci * 8192 + k * 64 + sq * 16;
      u32x4 w; w.x = cvt_pk_bf16(vals[0], vals[1]); w.y = cvt_pk_bf16(vals[2], vals[3]); w.z = cvt_pk_bf16(vals[4], vals[5]); w.w = cvt_pk_bf16(vals[6], vals[7]); *(u32x4*)o = w;
      w.x = cvt_pk_bf16(vals[8], vals[9]); w.y = cvt_pk_bf16(vals[10], vals[11]); w.z = cvt_pk_bf16(vals[12], vals[13]); w.w = cvt_pk_bf16(vals[14], vals[15]); *(u32x4*)(o + 8) = w; }
    {
        const int tm = wave >> 1, tnb = (wave & 1) * 2;
        f32x4 kk[2] = {(f32x4){0.f, 0.f, 0.f, 0.f}, (f32x4){0.f, 0.f, 0.f, 0.f}}, qk[2] = {(f32x4){0.f, 0.f, 0.f, 0.f}, (f32x4){0.f, 0.f, 0.f, 0.f}};
#pragma unroll
        for (int kx = 0; kx < 4; ++kx) { const bf16x8 ak = ldfrag(Kn, 16 * tm + l16, 136, kx * 32 + quad * 8), aq = ldfrag(Qn, 16 * tm + l16, 136, kx * 32 + quad * 8);
#pragma unroll
            for (int i = 0; i < 2; ++i) { const bf16x8 bk = ldfrag(Kn, 16 * (tnb + i) + l16, 136, kx * 32 + quad * 8); kk[i] = MFMA16(ak, bk, kk[i]); qk[i] = MFMA16(bk, aq, qk[i]); } }
#pragma unroll
        for (int i = 0; i < 2; ++i) {
            { const int s = 16 * (tnb + i) + l16; const float gs = gcs[s]; f32x4 m;
#pragma unroll
              for (int j = 0; j < 4; ++j) { const int tt = 16 * tm + 4 * quad + j; m[j] = tt > s ? betas[tt] * kk[i][j] * __expf(gcs[tt] - gs) : 0.f; }
              *(LAS f32x4*)(MT + s * 68 + 16 * tm + 4 * quad) = m;
#pragma unroll
              for (int j = 0; j < 4; ++j) MB[(16 * tm + 4 * quad + j) * 72 + s] = f2bf(m[j]); }
            { const int tt = 16 * tm + l16, s0 = 16 * (tnb + i) + 4 * quad; const float gt_ = gcs[tt]; float w4[4];
#pragma unroll
              for (int j = 0; j < 4; ++j) { const int s = s0 + j; w4[j] = s <= tt ? qk[i][j] * __expf(gt_ - gcs[s]) : 0.f; }
              u32x2 o; o.x = cvt_pk_bf16(w4[0], w4[1]); o.y = cvt_pk_bf16(w4[2], w4[3]); *(u32x2*)((bf16_t*)(aux + AUX_QK) + (size_t)ci * 4096 + tt * 64 + s0) = o; }
        }
    }
    __syncthreads();
    { const float bt = betas[t], be = bt * egs[t];
#pragma unroll
      for (int q4 = 0; q4 < 4; ++q4) { LAS f32x4* vp = (LAS f32x4*)(Vf + t * 128 + cg * 16 + q4 * 4); *vp = *vp * bt; LAS f32x4* kp = (LAS f32x4*)(Kf + t * 128 + cg * 16 + q4 * 4); *kp = *kp * be; } }
    __syncthreads();
#pragma unroll
    for (int ib = 0; ib < 4; ++ib) {
        if (tid < 256) {
            const int c = tid; const LAS float* R = c < 128 ? Vf + c : Kf + (c - 128); float r[16];
#pragma unroll
            for (int j = 0; j < 16; ++j) r[j] = R[(16 * ib + j) * 128];
#pragma unroll
            for (int s = 0; s < 15; ++s) {
#pragma unroll
                for (int v4 = (s + 1) >> 2; v4 < 4; ++v4) { const f32x4 mv = *(const LAS f32x4*)(MT + (16 * ib + s) * 68 + 16 * ib + 4 * v4);
#pragma unroll
                    for (int e = 0; e < 4; ++e) { const int tt = 4 * v4 + e; if (tt > s) r[tt] -= mv[e] * r[s]; } }
            }
            u32x4 w0, w1; w0.x = cvt_pk_bf16(r[0], r[1]); w0.y = cvt_pk_bf16(r[2], r[3]); w0.z = cvt_pk_bf16(r[4], r[5]); w0.w = cvt_pk_bf16(r[6], r[7]);
            w1.x = cvt_pk_bf16(r[8], r[9]); w1.y = cvt_pk_bf16(r[10], r[11]); w1.z = cvt_pk_bf16(r[12], r[13]); w1.w = cvt_pk_bf16(r[14], r[15]);
            if (c < 128) { bf16_t* o = (bf16_t*)(aux + AUX_UT) + (size_t)ci * 8192 + c * 64 + 16 * ib; *(u32x4*)o = w0; *(u32x4*)(o + 8) = w1; }
            else { bf16_t* o = (bf16_t*)(aux + AUX_W) + (size_t)ci * 8192 + (size_t)(16 * ib) * 128 + (c - 128);
#pragma unroll
                for (int j = 0; j < 16; ++j) o[j * 128] = f2bf(r[j]); }
            if (ib < 3) { *(LAS u32x4*)(XT + c * 64 + 16 * ib) = w0; *(LAS u32x4*)(XT + c * 64 + 16 * ib + 8) = w1; }
        }
        if (ib < 3) {
            __syncthreads();
#pragma unroll
            for (int q = 0; q < 2 * (3 - ib); ++q) { const int T = wave + 8 * q, tr = T >> 4, tc = T & 15;
                bf16x8 a = (bf16x8){0, 0, 0, 0, 0, 0, 0, 0}, bq = (bf16x8){0, 0, 0, 0, 0, 0, 0, 0};
                if (quad < 2) { a = ldfrag(MB, 16 * (ib + 1 + tr) + l16, 72, 16 * ib + quad * 8); bq = *(const LAS bf16x8*)(XT + (16 * tc + l16) * 64 + 16 * ib + quad * 8); }
                const f32x4 acc = MFMA16(a, bq, ((f32x4){0.f, 0.f, 0.f, 0.f}));
                LAS float* R = tc < 8 ? Vf + 16 * tc + l16 : Kf + 16 * (tc - 8) + l16;
#pragma unroll
                for (int j = 0; j < 4; ++j) R[(16 * (ib + 1 + tr) + 4 * quad + j) * 128] -= acc[j]; }
            __syncthreads();
        }
    }
}

__device__ void dn_scan_item(const DP& p, int l, int b, int h, LAS unsigned char* lds) {
    lds = launder_lds(lds);
    const int tid = my_tid(), lane = tid & 63, wave = __builtin_amdgcn_readfirstlane(tid >> 6), l16 = lane & 15, quad = lane >> 4;
    bf16_t* PROJ = (bf16_t*)(p.ws() + WS_PROJ); const unsigned char* aux = p.ws() + WS_AUX;
    LAS bf16_t* Ws = (LAS bf16_t*)(lds + 0); LAS bf16_t* QGs = (LAS bf16_t*)(lds + 17408); LAS bf16_t* QKs = (LAS bf16_t*)(lds + 34816);
    LAS bf16_t* KDTs = (LAS bf16_t*)(lds + 44032); LAS bf16_t* VnT = (LAS bf16_t*)(lds + 62464); LAS bf16_t* ST = (LAS bf16_t*)(lds + 80896);
    LAS float* red = (LAS float*)(lds + 115712);
    const size_t row0 = (size_t)b * SEQ; const size_t sidx = (size_t)(l * NB + b) * 4 + h; const int ci0 = (b * 4 + h) * 32;
    __syncthreads();
    for (int i = tid; i < 128 * 136 / 2; i += 512) ((LAS unsigned*)ST)[i] = 0u;
    f32x4 Sacc[8];
#pragma unroll
    for (int i = 0; i < 8; ++i) Sacc[i] = (f32x4){0.f, 0.f, 0.f, 0.f};
    const int tm = wave >> 1, tnb4 = (wave & 1) * 4;
    f32x4 nwv[4];
#pragma unroll
    for (int i = 0; i < 4; ++i) nwv[i] = *(const f32x4*)(p.in(I_DNW) + l * 128 + 16 * (tnb4 + i) + 4 * quad);
    u32x4 w1, w2, g1, g2, k1, k2, qk1; u32x2 ut[4]; float eg = 1.f;
#define DN_LOAD(n_) do { const size_t ci_ = (size_t)(ci0 + (n_)); \
        const bf16_t* wg = (const bf16_t*)(aux + AUX_W) + ci_ * 8192; w1 = *(const u32x4*)(wg + tid * 8); w2 = *(const u32x4*)(wg + (tid + 512) * 8); \
        const bf16_t* qg = (const bf16_t*)(aux + AUX_QG) + ci_ * 8192; g1 = *(const u32x4*)(qg + tid * 8); g2 = *(const u32x4*)(qg + (tid + 512) * 8); \
        const bf16_t* kd = (const bf16_t*)(aux + AUX_KDT) + ci_ * 8192; k1 = *(const u32x4*)(kd + tid * 8); k2 = *(const u32x4*)(kd + (tid + 512) * 8); \
        qk1 = *(const u32x4*)((const bf16_t*)(aux + AUX_QK) + ci_ * 4096 + tid * 8); \
        const bf16_t* ug = (const bf16_t*)(aux + AUX_UT) + ci_ * 8192; \
        _Pragma("unroll") for (int i = 0; i < 4; ++i) ut[i] = *(const u32x2*)(ug + (16 * (tnb4 + i) + l16) * 64 + 16 * tm + 4 * quad); \
        eg = ((const float*)(aux + AUX_EG))[ci_]; } while (0)
#define DN_STORE() do { \
        *(LAS u32x4*)(Ws + (tid >> 4) * 136 + (tid & 15) * 8) = w1; *(LAS u32x4*)(Ws + ((tid + 512) >> 4) * 136 + (tid & 15) * 8) = w2; \
        *(LAS u32x4*)(QGs + (tid >> 4) * 136 + (tid & 15) * 8) = g1; *(LAS u32x4*)(QGs + ((tid + 512) >> 4) * 136 + (tid & 15) * 8) = g2; \
        *(LAS u32x4*)(KDTs + (tid >> 3) * 72 + (tid & 7) * 8) = k1; *(LAS u32x4*)(KDTs + ((tid + 512) >> 3) * 72 + (tid & 7) * 8) = k2; \
        *(LAS u32x4*)(QKs + (tid >> 3) * 72 + (tid & 7) * 8) = qk1; } while (0)
    DN_LOAD(0);
    DN_STORE();
    const int t = 16 * tm + l16;
    for (int n = 0; n < 32; ++n) {
        __syncthreads();
        const float egc = eg; u32x2 utc[4];
#pragma unroll
        for (int i = 0; i < 4; ++i) utc[i] = ut[i];
        if (n + 1 < 32) DN_LOAD(n + 1);
        u32x2 gpre[4];
        { const bf16_t* gp_ = PROJ + (row0 + (size_t)n * 64 + t) * PW + 1536 + h * 128;
#pragma unroll
          for (int i = 0; i < 4; ++i) gpre[i] = *(const u32x2*)(gp_ + 16 * (tnb4 + i) + 4 * quad); }
        {
            f32x4 acc[4];
#pragma unroll
            for (int i = 0; i < 4; ++i) acc[i] = (f32x4){0.f, 0.f, 0.f, 0.f};
#pragma unroll
            for (int kx = 0; kx < 4; ++kx) { const bf16x8 a = ldfrag(Ws, 16 * tm + l16, 136, kx * 32 + quad * 8);
#pragma unroll
                for (int i = 0; i < 4; ++i) { const bf16x8 bq = ldfrag(ST, 16 * (tnb4 + i) + l16, 136, kx * 32 + quad * 8); acc[i] = MFMA16(a, bq, acc[i]); } }
#pragma unroll
            for (int i = 0; i < 4; ++i) { const float v0 = bflo(utc[i].x) - acc[i][0], v1 = bfhi(utc[i].x) - acc[i][1], v2 = bflo(utc[i].y) - acc[i][2], v3 = bfhi(utc[i].y) - acc[i][3];
                u32x2 o; o.x = cvt_pk_bf16(v0, v1); o.y = cvt_pk_bf16(v2, v3); *(LAS u32x2*)(VnT + (16 * (tnb4 + i) + l16) * 72 + 16 * tm + 4 * quad) = o; }
        }
        __syncthreads();
        f32x4 o2[4];
        {
#pragma unroll
            for (int i = 0; i < 4; ++i) o2[i] = (f32x4){0.f, 0.f, 0.f, 0.f};
#pragma unroll
            for (int kx = 0; kx < 4; ++kx) { const bf16x8 a = ldfrag(QGs, t, 136, kx * 32 + quad * 8);
#pragma unroll
                for (int i = 0; i < 4; ++i) { const bf16x8 bq = ldfrag(ST, 16 * (tnb4 + i) + l16, 136, kx * 32 + quad * 8); o2[i] = MFMA16(bq, a, o2[i]); } }
#pragma unroll
            for (int kx = 0; kx < 2; ++kx) { const bf16x8 a = ldfrag(QKs, t, 72, kx * 32 + quad * 8);
#pragma unroll
                for (int i = 0; i < 4; ++i) { const bf16x8 bq = ldfrag(VnT, 16 * (tnb4 + i) + l16, 72, kx * 32 + quad * 8); o2[i] = MFMA16(bq, a, o2[i]); } }
            float ssq = 0.f;
#pragma unroll
            for (int i = 0; i < 4; ++i) ssq += (o2[i][0] * o2[i][0] + o2[i][1] * o2[i][1]) + (o2[i][2] * o2[i][2] + o2[i][3] * o2[i][3]);
            ssq += __shfl_xor(ssq, 16); ssq += __shfl_xor(ssq, 32);
            if (quad == 0) red[t * 2 + (wave & 1)] = ssq;
        }
        {
#pragma unroll
            for (int tn = 0; tn < 8; ++tn) Sacc[tn] = Sacc[tn] * egc;
#pragma unroll
            for (int kx = 0; kx < 2; ++kx) { const bf16x8 a = ldfrag(KDTs, 16 * wave + l16, 72, kx * 32 + quad * 8);
#pragma unroll
                for (int tn = 0; tn < 8; ++tn) { const bf16x8 bq = ldfrag(VnT, 16 * tn + l16, 72, kx * 32 + quad * 8); Sacc[tn] = MFMA16(a, bq, Sacc[tn]); } }
        }
        __syncthreads();
#pragma unroll
        for (int tn = 0; tn < 8; ++tn) { u32x2 o; o.x = cvt_pk_bf16(Sacc[tn][0], Sacc[tn][1]); o.y = cvt_pk_bf16(Sacc[tn][2], Sacc[tn][3]); *(LAS u32x2*)(ST + (16 * tn + l16) * 136 + 16 * wave + 4 * quad) = o; }
        {
            const float rs = rsqrtf((red[t * 2] + red[t * 2 + 1]) * (1.0f / 128.0f) + 1e-6f);
            bf16_t* gp = PROJ + (row0 + (size_t)n * 64 + t) * PW + 1536 + h * 128;
#pragma unroll
            for (int i = 0; i < 4; ++i) { const int c0 = 16 * (tnb4 + i) + 4 * quad; const u32x2 gv = gpre[i]; const float g4[4] = {bflo(gv.x), bfhi(gv.x), bflo(gv.y), bfhi(gv.y)};
                const f32x4 nw = nwv[i]; float r4[4];
#pragma unroll
                for (int j = 0; j < 4; ++j) r4[j] = o2[i][j] * rs * nw[j] * siluf_(g4[j]);
                u32x2 ov; ov.x = cvt_pk_bf16(r4[0], r4[1]); ov.y = cvt_pk_bf16(r4[2], r4[3]); *(u32x2*)(gp + c0) = ov; }
        }
        if (n + 1 < 32) DN_STORE();
    }
    {
        float* so = p.out() + O_PS + sidx * 16384;
#pragma unroll
        for (int tn = 0; tn < 8; ++tn)
#pragma unroll
            for (int j = 0; j < 4; ++j) so[(16 * wave + 4 * quad + j) * 128 + 16 * tn + l16] = Sacc[tn][j];
    }
    __syncthreads();
#undef DN_LOAD
#undef DN_STORE
}
#define XB_TMO      128
#define XB_XCNT(j)  (256  + 64 * (j))
#define XB_XSUB(j)  (1280 + 64 * (j))
#define XB_XGEN(j)  (2304 + 64 * (j))
#define XB_TOP      3328
#define XB_TOPGEN   3392
#define XCD_BAR_WORDS 3456
#define XB_SPIN_CAP (1u << 18)

__device__ __forceinline__ unsigned xb_ld(unsigned* p)              { return __hip_atomic_load(p, __ATOMIC_RELAXED, __HIP_MEMORY_SCOPE_AGENT); }
__device__ __forceinline__ unsigned xb_add(unsigned* p, unsigned v) { return __hip_atomic_fetch_add(p, v, __ATOMIC_RELAXED, __HIP_MEMORY_SCOPE_AGENT); }
__device__ __forceinline__ unsigned xb_xcc_id() { return (unsigned)__builtin_amdgcn_s_getreg((3 << 11) | 20) & 0xFu; }
#define XB_SPIN(cond, bar) do { unsigned _sp = 0; while (cond) { __builtin_amdgcn_s_sleep(1); \
    if ((++_sp & 255u) == 0u) { if (xb_ld(&(bar)[XB_TMO])) break; if (_sp > XB_SPIN_CAP) { atomicAdd(&(bar)[XB_TMO], 1u); break; } } } } while (0)

struct XcdBarrier {
    unsigned* bar; unsigned x;
    volatile LAS unsigned* st;
};

__device__ __forceinline__ XcdBarrier xcd_barrier_post(unsigned* bar, volatile LAS unsigned* st) {
    XcdBarrier b; b.bar = bar; b.x = xb_xcc_id(); b.st = st;
    if (threadIdx.x == 0) (void)xb_add(&bar[XB_XCNT(b.x)], 1u);
    return b;
}
__device__ __forceinline__ void xcd_barrier_complete(unsigned* bar, unsigned x, unsigned& nloc, unsigned& nx) {
    const unsigned G = gridDim.x * gridDim.y * gridDim.z;
    unsigned sum, cnt, mine, sp = 0u;
    for (;;) {
        sum = 0u; cnt = 0u; mine = 0u;
#pragma unroll
        for (unsigned j = 0; j < 16; ++j) { const unsigned c = xb_ld(&bar[XB_XCNT(j)]); sum += c; cnt += (c > 0u) ? 1u : 0u; mine = (j == x) ? c : mine; }
        if (sum == G) break;
        __builtin_amdgcn_s_sleep(1);
        if ((++sp & 255u) == 0u) { if (xb_ld(&bar[XB_TMO])) break; if (sp > XB_SPIN_CAP) { atomicAdd(&bar[XB_TMO], 1u); break; } }
    }
    nloc = mine > 0u ? mine : 1u; nx = cnt > 0u ? cnt : 1u;
}

__device__ __forceinline__ void xcd_barrier(const XcdBarrier& b) {
    asm volatile("s_waitcnt vmcnt(0)" ::: "memory");
    __syncthreads();
    if (threadIdx.x == 0) {
        unsigned* bar = b.bar;
        __builtin_amdgcn_s_waitcnt(0);
        unsigned nloc = b.st[0], nx = b.st[1];
        if (nloc == 0u) { xcd_barrier_complete(bar, b.x, nloc, nx); b.st[0] = nloc; b.st[1] = nx; }
        const unsigned old = xb_add(&bar[XB_XSUB(b.x)], 1u);
        const unsigned gen = old / nloc;
        if (old + 1u == (gen + 1u) * nloc) {
            __builtin_amdgcn_fence(__ATOMIC_RELEASE, "agent");
            asm volatile("s_waitcnt vmcnt(0)" ::: "memory");
            const unsigned og = xb_add(&bar[XB_TOP], 1u);
            const unsigned tg = og / nx;
            if (og + 1u == (tg + 1u) * nx) xb_add(&bar[XB_TOPGEN], 1u);
            else XB_SPIN(xb_ld(&bar[XB_TOPGEN]) == tg, bar);
            __builtin_amdgcn_fence(__ATOMIC_ACQUIRE, "agent");
            xb_add(&bar[XB_XGEN(b.x)], 1u);
            asm volatile("s_waitcnt vmcnt(0)" ::: "memory");
        } else {
            XB_SPIN(xb_ld(&bar[XB_XGEN(b.x)]) == gen, bar);
            __builtin_amdgcn_fence(__ATOMIC_ACQUIRE, "agent");
            asm volatile("s_waitcnt vmcnt(0)" ::: "memory");
        }
    }
    __syncthreads();
}

__device__ __forceinline__ int next_item(unsigned* ctr, LAS int* slot) {
    __syncthreads();
    if (my_tid() == 0) *slot = (int)atomicAdd(ctr, 1u);
    __syncthreads();
    return __builtin_amdgcn_readfirstlane(*slot);
}

__device__ void run_phase(int ph, LAS unsigned char* lds) {
    lds = launder_lds(lds);
    DP p{(const LAS unsigned long long*)(lds + MISC_OFF + 64)};
    const int G = gridDim.x, bx = my_bid();
    bf16_t* X = (bf16_t*)(p.ws() + WS_X); bf16_t* PROJ = (bf16_t*)(p.ws() + WS_PROJ); bf16_t* MG = (bf16_t*)(p.ws() + WS_AUX); bf16_t* H = (bf16_t*)(p.ws() + WS_AUX);
    bf16_t* T1 = (bf16_t*)(p.ws() + WS_PROJ); bf16_t* U = (bf16_t*)(p.ws() + WS_PROJ); bf16_t* T2 = (bf16_t*)(p.ws() + WS_PROJ + OFF_T2);
    unsigned* ctr = (unsigned*)(p.ws() + WS_CTR); float* TS1 = (float*)(p.ws() + WS_AUX + (size_t)36 * 1024 * 1024); bf16_t* PZ = (bf16_t*)(p.ws() + WS_AUX + (size_t)62 * 1024 * 1024); float* TS2 = (float*)(p.ws() + WS_TS2);
    if (ph == 0) { phase_prep(p, lds); return; }
    const int l = (ph - 1) / 9, s = (ph - 1) % 9;
    const bf16_t* WinT = (const bf16_t*)(p.ws() + WS_WIN) + (size_t)l * 9216 * 1024;
    if (s == 0) {
        pg8::Gemm g{X, WinT, NTOK, PW, DM, DM, 0, 0, DM}; pg8::Order S; S.init(NTOK, PW, 1, G, bx, DM);
        pg8::EpiBf16<0> E{PROJ, PW};
        pg8::gemm_phase(lds, g, S, E);
        phase_small(p, l, lds);
    } else if (s == 1) {
        LAS int* slot = (LAS int*)(lds + MISC_OFF);
        for (;;) {
            const int it = next_item(ctr + l * 4, slot);
            if (it >= 1024) break;
            dn_prep_item(p, l, it >> 7, (it >> 2) & 31, it & 3, lds);
        }
    } else if (s == 2) {
        if (bx < 32) scan_item<2>(p, l, bx >> 2, bx & 3, lds);
        else if (bx < 64) scan_item<1>(p, l, (bx - 32) >> 2, bx & 3, lds);
        else if (bx < 96) dn_scan_item(p, l, (bx - 64) >> 2, bx & 3, lds);
        else {
            pg8::Gemm g{X, WinT + (size_t)PW * 1024, NTOK, NG, DM, DM, 0, 0, DM}; pg8::Order S; S.init(NTOK, NG, 1, G - 96, bx - 96, DM);
            pg8::EpiGateU8 E{(unsigned char*)PROJ, p.ws() + WS_SGS};
            pg8::gemm_phase(lds, g, S, E);
        }
        { LAS int* slot = (LAS int*)(lds + MISC_OFF);
          for (;;) {
            const int j = next_item(ctr + l * 4 + 1, slot);
            if (j >= 1536) break;
            const int mix = j / 512, rem = j % 512, b = rem >> 2, h = rem & 3;
            if (mix == 0) rec_item<0>(p, l, false, b, h, lds); else if (mix == 1) rec_item<1>(p, l, false, b, h, lds); else rec_item<2>(p, l, false, b, h, lds);
           }
          if (l + 1 < NL) for (;;) {
            const int i = next_item(ctr + l * 4 + 2, slot);
            if (i >= 4992) break;
            prep_one_tile(p, layer_tile(l + 1, i), lds);
          } }
    } else if (s == 3) {
        pg8::Gemm g{PROJ + 1536, (const bf16_t*)(p.ws() + WS_WBR) + (size_t)l * 3 * 1024 * 512, NTOK, DM, 512, PW, 2048, 1024 * 512, 512}; pg8::Order S; S.init(NTOK, DM, 3, G, bx, 512, G == 256 ? -1 : 0);
        pg8::EpiMerge E{(const unsigned char*)PROJ, p.ws() + WS_SGS, MG, PZ};
        pg8::gemm_phase(lds, g, S, E);
    } else if (s == 4) {
        pg8::Gemm g{MG, (const bf16_t*)(p.ws() + WS_WOUT) + (size_t)l * 1024 * 1024, NTOK, DM, DM, DM, DM / 4, DM / 4, DM, PZ, 512 * 1024, 4}; pg8::Order S; S.init(NTOK, DM, 1, G, bx, DM, G == 256 ? 12 : 0, 4);
        pg8::EpiRes E{X, T1, TS1};
        pg8::gemm_phase(lds, g, S, E);
    } else if (s == 5) {
        phase_ln(T1, TS1, G == 256 ? 12 : 0, p.in(I_LN1G) + l * DM, p.in(I_LN1B) + l * DM, H, nullptr, nullptr);
    } else if (s == 6) {
        pg8::Gemm g{H, (const bf16_t*)(p.ws() + WS_WFF1) + (size_t)l * 4096 * 1024, NTOK, DFF, DM, DM, 0, 0, DM}; pg8::Order S; S.init(NTOK, DFF, 1, G, bx, DM);
        pg8::EpiBf16<1> E{U, DFF};
        pg8::gemm_phase(lds, g, S, E);
    } else if (s == 7) {
        pg8::Gemm g{U, (const bf16_t*)(p.ws() + WS_WFF2) + (size_t)l * 1024 * 4096, NTOK, DM, DFF, DFF, DFF / 8, DFF / 8, DFF, U + (size_t)NP * DFF, 0, 8}; pg8::Order S; S.init(NTOK, DM, 1, G, bx, DFF, G == 256 ? 8 : 0, 8);
        pg8::EpiRes E{H, T2, TS2};
        pg8::gemm_phase(lds, g, S, E);
    } else {
        const bool lastl = (l == NL - 1);
        phase_ln(T2, TS2, G == 256 ? 8 : 0, p.in(I_LN2G) + l * DM, p.in(I_LN2B) + l * DM, X, lastl ? p.out() + O_YP : nullptr, lastl ? p.out() + O_YS : nullptr);
    }
}

constexpr int NPHASE = 1 + 9 * NL;
__global__ void __launch_bounds__(512) mega(Params kp, int ph_lo, int ph_hi) {
    extern __shared__ __attribute__((aligned(16))) unsigned char lds_raw[];
    LAS unsigned char* lds = (LAS unsigned char*)lds_raw;
    cg::grid_group grid = cg::this_grid();
    LAS unsigned long long* tab = (LAS unsigned long long*)(lds + MISC_OFF + 64);
    if (threadIdx.x == 0) {
#pragma unroll
        for (int i = 0; i < 26; ++i) tab[i] = (unsigned long long)kp.in[i];
        tab[26] = (unsigned long long)kp.out; tab[27] = (unsigned long long)kp.ws; }
    if (threadIdx.x < 4) ((LAS unsigned*)(lds + MISC_OFF + 16))[threadIdx.x] = 0u;
    __syncthreads();
    const XcdBarrier xb = xcd_barrier_post((unsigned*)(kp.ws + WS_CTR + 1024), (volatile LAS unsigned*)(lds + MISC_OFF + 16));
    for (int ph = ph_lo; ph < ph_hi; ++ph) {
        run_phase(ph, lds);
        if (ph + 1 < ph_hi) {
            if (ph == ph_lo) grid.sync();
            else xcd_barrier(xb);
        }
    }
}

extern "C" void kernel_launch(void* const* d_in, const int* in_sizes, int n_in, void* d_out, int out_size, void* d_ws, size_t ws_size, hipStream_t stream) {
    static int grid = 0;
    if (grid == 0) {
        int dev = 0, cus = 0, per_cu = 0;
        (void)hipGetDevice(&dev);
        (void)hipDeviceGetAttribute(&cus, hipDeviceAttributeMultiprocessorCount, dev);
        (void)hipFuncSetAttribute((const void*)mega, hipFuncAttributeMaxDynamicSharedMemorySize, LDS_BYTES);
        (void)hipOccupancyMaxActiveBlocksPerMultiprocessor(&per_cu, (const void*)mega, 512, LDS_BYTES);
        if (per_cu < 1) per_cu = 1;
        grid = cus * per_cu;
        if (n_in != 26 || (long)out_size != O_END || ws_size < WS_END) { fprintf(stderr, "kernel_launch: unexpected sizes n_in %d out %d ws %zu (need %zu)\n", n_in, out_size, ws_size, (size_t)WS_END); }
    }
    (void)hipMemsetAsync((char*)d_ws + WS_CTR, 0, SZ_CTR, stream);
    Params p{};
    for (int i = 0; i < 26; ++i) p.in[i] = (const float*)d_in[i];
    p.out = (float*)d_out; p.ws = (unsigned char*)d_ws;
    int lo = 0, hi = NPHASE;
    void* args[] = {&p, &lo, &hi};
    hipError_t e = hipLaunchCooperativeKernel((const void*)mega, dim3(grid), dim3(512), args, LDS_BYTES, stream);
    if (e != hipSuccess) fprintf(stderr, "cooperative launch failed: %s (grid %d)\n", hipGetErrorString(e), grid);
}
```

```cpp
#include <hip/hip_runtime.h>
#include <hip/hip_cooperative_groups.h>
#include <cstdio>
namespace cg = cooperative_groups;

#define LAS __attribute__((address_space(3)))
typedef unsigned short bf16_t;
typedef short bf16x8 __attribute__((ext_vector_type(8)));
typedef float f32x4 __attribute__((ext_vector_type(4)));
typedef float f32x2 __attribute__((ext_vector_type(2)));
typedef unsigned u32x4 __attribute__((ext_vector_type(4)));
typedef unsigned u32x2 __attribute__((ext_vector_type(2)));

typedef __bf16 bf16x2_t __attribute__((ext_vector_type(2)));
__device__ __forceinline__ unsigned cvt_pk_bf16(float lo, float hi) { const f32x2 v = {lo, hi}; const bf16x2_t b = __builtin_convertvector(v, bf16x2_t); return __builtin_bit_cast(unsigned, b); }
__device__ __forceinline__ bf16_t f2bf(float f) { return (bf16_t)(cvt_pk_bf16(f, 0.f) & 0xffffu); }
__device__ __forceinline__ float bf2f(bf16_t b) { return __uint_as_float(((unsigned)b) << 16); }
__device__ __forceinline__ float bflo(unsigned w) { return __uint_as_float(w << 16); }
__device__ __forceinline__ float bfhi(unsigned w) { return __uint_as_float(w & 0xffff0000u); }
__device__ __forceinline__ float sigmoidf_(float x) { return __builtin_amdgcn_rcpf(1.0f + __expf(-x)); }
__device__ __forceinline__ float siluf_(float x) { return x * __builtin_amdgcn_rcpf(1.0f + __expf(-x)); }
__device__ __forceinline__ float softplusf_(float x) { return fmaxf(x, 0.f) + log1pf(__expf(-fabsf(x))); }
__device__ __forceinline__ float logsigmoidf_(float x) { return fminf(x, 0.f) - log1pf(__expf(-fabsf(x))); }

__device__ __forceinline__ int my_tid() { int t = threadIdx.x; asm volatile("" : "+v"(t)); return t; }
__device__ __forceinline__ int my_bid() { int t = blockIdx.x; asm volatile("" : "+s"(t)); return t; }
__device__ __forceinline__ LAS unsigned char* launder_lds(LAS unsigned char* q) { unsigned v = (unsigned)(unsigned long long)q; asm volatile("" : "+s"(v)); return (LAS unsigned char*)(unsigned long long)v; }
constexpr int NP = 16384, NTOK = 16896, DM = 1024, PW = 6144, NG = 3072, DFF = 4096, NL = 2, SEQ = 2048, NB = 8, NDB = 128;
constexpr float ALPHA = 1.41421356237f;
constexpr float DKS = 0.08838834764831845f;
enum { I_XP = 0, I_XS, I_SCONV, I_SS, I_SR, I_SC, I_SN, I_SM, I_WIN, I_CONVW, I_ALOG, I_DTB, I_DNW, I_IB, I_FB, I_MLW, I_WBA, I_WBB, I_WBC, I_WOUT, I_LN1G, I_LN1B, I_WFF1, I_WFF2, I_LN2G, I_LN2B };
constexpr long O_YP = 0, O_YS = O_YP + (long)NP * DM, O_PCONV = O_YS + 512L * DM, O_PS = O_PCONV + 2L * 8 * 3 * 1536, O_PR = O_PS + 2L * 8 * 4 * 16384, O_PC = O_PR + 2L * 8 * 4 * 16384,
               O_PN = O_PC + 2L * 8 * 4 * 16384, O_PM = O_PN + 2L * 8 * 4 * 128, O_SCONV = O_PM + 2L * 8 * 4, O_SS = O_SCONV + 2L * 128 * 3 * 1536, O_SR = O_SS + 2L * 128 * 4 * 16384,
               O_SC = O_SR + 2L * 128 * 4 * 16384, O_SN = O_SC + 2L * 128 * 4 * 16384, O_SM = O_SN + 2L * 128 * 4 * 128, O_END = O_SM + 2L * 128 * 4;
static_assert(O_END == 72172608L, "output size");
constexpr size_t WS_WIN = 0, SZ_WIN = (size_t)NL * 9216 * 1024 * 2;
constexpr size_t WS_WBR = WS_WIN + SZ_WIN, SZ_WBR = (size_t)NL * 3 * 1024 * 512 * 2;
constexpr size_t WS_WOUT = WS_WBR + SZ_WBR, SZ_WOUT = (size_t)NL * 1024 * 1024 * 2;
constexpr size_t WS_WFF1 = WS_WOUT + SZ_WOUT, SZ_WFF = (size_t)NL * 4096 * 1024 * 2;
constexpr size_t WS_WFF2 = WS_WFF1 + SZ_WFF;
constexpr size_t WS_X = WS_WFF2 + SZ_WFF, SZ_X = (size_t)NTOK * DM * 2;
constexpr size_t WS_PROJ = WS_X + SZ_X, SZ_PROJ = (size_t)NTOK * PW * 2;
constexpr size_t WS_AUX = WS_PROJ + SZ_PROJ, SZ_AUX = (size_t)80 * 1024 * 1024;
constexpr size_t WS_SMALL = WS_AUX + SZ_AUX, SZ_SMALL = (size_t)NTOK * 16 * 4;
constexpr size_t WS_ROPE = WS_SMALL + SZ_SMALL, SZ_ROPE = (size_t)2052 * 64 * 2 * 4;
constexpr size_t WS_CTR = WS_ROPE + SZ_ROPE, SZ_CTR = 16384;
constexpr size_t WS_SGS = WS_CTR + SZ_CTR, SZ_SGS = (size_t)512 * 3072;
constexpr size_t WS_TS1 = WS_SGS + SZ_SGS, SZ_TSLAB = (size_t)512 * 1024 * 4;
constexpr size_t WS_TS2 = WS_TS1 + 4 * SZ_TSLAB;
constexpr size_t WS_END = WS_TS2 + 8 * SZ_TSLAB;
static_assert(WS_END <= (size_t)439575680, "workspace");
constexpr size_t OFF_T2 = (size_t)NTOK * DFF * 2;
static_assert(OFF_T2 + (size_t)NTOK * DM * 4 <= SZ_PROJ, "T2 fits");
constexpr size_t AUX_W = 0, AUX_UT = AUX_W + (size_t)1024 * 16384, AUX_QG = AUX_UT + (size_t)1024 * 16384, AUX_KDT = AUX_QG + (size_t)1024 * 16384, AUX_QK = AUX_KDT + (size_t)1024 * 16384, AUX_EG = AUX_QK + (size_t)1024 * 8192;
static_assert(AUX_EG + 4096 <= SZ_AUX, "aux");

constexpr int LDS_BYTES = 131072 + 1024;
constexpr int MISC_OFF = 131072;

struct Params { const float* in[26]; float* out; unsigned char* ws; };
__device__ __forceinline__ unsigned long long ld_uniform64(const LAS unsigned long long* a) { const unsigned long long v = *a; const unsigned lo = __builtin_amdgcn_readfirstlane((unsigned)v), hi = __builtin_amdgcn_readfirstlane((unsigned)(v >> 32)); return ((unsigned long long)hi << 32) | lo; }
struct DP { const LAS unsigned long long* tab;
    __device__ __forceinline__ const float* in(int i) const { return (const float*)(const __attribute__((address_space(1))) float*)ld_uniform64(tab + i); }
    __device__ __forceinline__ float* out() const { return (float*)(__attribute__((address_space(1))) float*)ld_uniform64(tab + 26); }
    __device__ __forceinline__ unsigned char* ws() const { return (unsigned char*)(__attribute__((address_space(1))) unsigned char*)ld_uniform64(tab + 27); } };
namespace pg8 {
constexpr int BM = 256, BK = 64, HALF = 128, HTB = HALF * BK * 2, STAGE_BYTES = 8 * HTB, NXCD = 8, WGM = 8;
__host__ __device__ __forceinline__ int lds_byte(int r, int c) { const int st = (r >> 4) * 2 + (c >> 5), rr = r & 15, cc = c & 31, ob = rr * 64 + cc * 2; return st * 1024 + (ob ^ (((ob >> 9) & 1) << 5)); }
__host__ __device__ __forceinline__ void stage_rc(int b, int& R, int& C) { const int st = b / 1024, sb = b % 1024, swz = sb ^ (((sb >> 9) & 1) << 5); R = (st >> 1) * 16 + swz / 64; C = (st & 1) * 32 + (swz % 64) / 2; }
__host__ __device__ __forceinline__ int perm32(int rho) { const int n = rho >> 4, i = rho & 15; return 8 * (i >> 2) + 4 * n + (i & 3); }

struct Unit { int pm, pn, z, kind, nt; };
struct Gemm { const bf16_t* A; const bf16_t* Bt; int M, N, K, lda; long zA, zB; int ldb; const bf16_t* A2; long zA2; int kdiv; };

struct Order {
    int nM, nN, nz, nwg, G, c, ntf, ksplit, ntp;
    __device__ void init(int M, int N, int nz_, int G_, int c_, int K, int ksplit_ = 0, int ntp_ = 0) { nM = M / BM; nN = N / BM; nz = nz_; nwg = nM * nN; G = G_; c = c_; ntf = K / BK; ksplit = ksplit_; ntp = ntp_; }
    __device__ bool next(int i, Unit& u) const {
        long L;
        if (ksplit == 0) { const int ti = i / nz; u.z = i - ti * nz; u.kind = 0; u.nt = ntf; L = (long)ti * G + c; if (c < 0 || L >= nwg) return false; }
        else {
            if (ksplit > 0) {
                if (i == 0) { u.z = 0; u.kind = 0; u.nt = ntf; L = c; }
                else if (i == 1 && c < 8 * ksplit) { const int j = c / ksplit; u.z = c - j * ksplit; u.kind = 1; u.nt = ntp; u.pm = 64 + (j >> 2); u.pn = j & 3; return true; }
                else return false;
            } else {
                if (i < nz) { u.z = i; u.kind = 0; u.nt = ntf; L = c; }
                else if (i == nz && c < 8 * nz) { const int j = c / nz; u.z = c - j * nz; u.kind = 2; u.nt = ntf; u.pm = 64 + (j >> 2); u.pn = j & 3; return true; }
                else return false;
            }
            int wgid = (int)L; { const int nw = 256, q = nw / NXCD, xcd = wgid % NXCD, off = wgid / NXCD; wgid = xcd * q + off; }
            const int nig = WGM * 4, gid = wgid / nig, fm = gid * WGM;
            u.pm = fm + ((wgid % nig) % WGM); u.pn = (wgid % nig) / WGM; return true;
        }
        int wgid = (int)L; { const int q = nwg / NXCD, r = nwg % NXCD, xcd = wgid % NXCD, off = wgid / NXCD; wgid = (xcd < r ? xcd * (q + 1) : r * (q + 1) + (xcd - r) * q) + off; }
        const int nig = WGM * nN, gid = wgid / nig, fm = gid * WGM, gsz = (nM - fm) < WGM ? (nM - fm) : WGM;
        u.pm = fm + ((wgid % nig) % gsz); u.pn = (wgid % nig) / gsz; return true;
    }
};

template <class Epi>
__device__ __forceinline__ void gemm_phase(LAS unsigned char* lds, const Gemm g, const Order& S, const Epi& E) {
    lds = launder_lds(lds);
    int tid_l = threadIdx.x; asm volatile("" : "+v"(tid_l));
    const int tid = tid_l, wid = __builtin_amdgcn_readfirstlane(tid >> 6), lane = tid & 63, wr = wid >> 2, wc = wid & 3, fr = lane & 15, fq = lane >> 4;
    const int K = g.ldb, lda = g.lda;
    unsigned voffA[2], voffB[2];
#pragma unroll
    for (int i = 0; i < 2; ++i) { int R, C; stage_rc(tid * 16 + i * 8192, R, C); const int Rb = Epi::PERM ? ((R & ~31) + perm32(R & 31)) : R;
        voffA[i] = (unsigned)(R * lda + C) * 2u; voffB[i] = (unsigned)(Rb * K + C) * 2u; }
    const size_t kstep = (size_t)(BK * 2);
    const size_t hstepA = (size_t)HALF * lda * 2, hstepB = (size_t)HALF * K * 2;
    const size_t tstepA = 2 * hstepA, tstepB = 2 * hstepB;
    const unsigned ldsw = (unsigned)wid * 1024u;
    const int aoff = lds_byte(wr * 64 + fr, fq * 8), boff = lds_byte(wc * 32 + fr, fq * 8);
#define PG8_SA(b, h) (((b) * 2 + (h)) * HTB)
#define PG8_SB(b, h) ((4 + (b) * 2 + (h)) * HTB)
#define PG8_STAGE(bufoff, gbase, voff) do { _Pragma("unroll") for (int _i = 0; _i < 2; ++_i) \
        __builtin_amdgcn_global_load_lds((const unsigned*)((const char*)(gbase) + (voff)[_i]), (LAS unsigned*)(lds + (bufoff) + ldsw + _i * 8192), 16, 0, 0); } while (0)
#define PG8_LDA(dst, b, h) do { _Pragma("unroll") for (int m = 0; m < 4; ++m) _Pragma("unroll") for (int k = 0; k < 2; ++k) dst[m][k] = *(const LAS bf16x8*)(lds + PG8_SA(b, h) + aoff + m * 2048 + k * 1024); } while (0)
#define PG8_LDB(dst, b, h) do { _Pragma("unroll") for (int n = 0; n < 2; ++n) _Pragma("unroll") for (int k = 0; k < 2; ++k) dst[n][k] = *(const LAS bf16x8*)(lds + PG8_SB(b, h) + boff + n * 2048 + k * 1024); } while (0)
#define PG8_MMA(ai, bj, At, Bt) do { __builtin_amdgcn_s_setprio(1); _Pragma("unroll") for (int m = 0; m < 4; ++m) _Pragma("unroll") for (int n = 0; n < 2; ++n) _Pragma("unroll") for (int k = 0; k < 2; ++k) \
        acc[ai][bj][m][n] = __builtin_amdgcn_mfma_f32_16x16x32_bf16(Bt[n][k], At[m][k], acc[ai][bj][m][n], 0, 0, 0); __builtin_amdgcn_s_setprio(0); } while (0)
#define PG8_WAIT_V(n) asm volatile("s_waitcnt vmcnt(" #n ")" ::: "memory")
#define PG8_WAIT_L(n) asm volatile("s_waitcnt lgkmcnt(" #n ")" ::: "memory")
#define PG8_BAR __builtin_amdgcn_s_barrier()
#define PG8_SCHED __builtin_amdgcn_sched_barrier(0)
    Unit cur, nxt; int ui = 0;
    if (!S.next(0, cur)) return;
    int nt = cur.nt;
    f32x4 acc[2][2][4][2];
#pragma unroll
    for (int a = 0; a < 2; ++a)
#pragma unroll
        for (int b = 0; b < 2; ++b)
#pragma unroll
            for (int m = 0; m < 4; ++m)
#pragma unroll
                for (int n = 0; n < 2; ++n) acc[a][b][m][n] = (f32x4){0.f, 0.f, 0.f, 0.f};
    bf16x8 At[4][2], B0[2][2], B1[2][2];
#define PG8_APTR(u_) ((u_).kind == 1 ? (const char*)(g.A2 + (size_t)((u_).z / g.kdiv) * g.zA2 + (size_t)((u_).z % g.kdiv) * g.zA) + (size_t)((u_).pm - 64) * tstepA : (const char*)(g.A + (size_t)(u_).z * g.zA) + (size_t)(u_).pm * tstepA)
#define PG8_BPTR(u_) ((const char*)(g.Bt + (size_t)((u_).kind == 1 ? (u_).z % g.kdiv : (u_).z) * g.zB) + (size_t)(u_).pn * tstepB)
    const char* cA = PG8_APTR(cur); const char* cB = PG8_BPTR(cur);
    PG8_STAGE(PG8_SB(0, 0), cB, voffB); PG8_STAGE(PG8_SA(0, 0), cA, voffA); PG8_STAGE(PG8_SB(0, 1), cB + hstepB, voffB); PG8_STAGE(PG8_SA(0, 1), cA + hstepA, voffA);
    if (wr == 1) PG8_BAR;
    PG8_WAIT_V(4); PG8_BAR;
    PG8_STAGE(PG8_SB(1, 0), cB + kstep, voffB); PG8_STAGE(PG8_SA(1, 0), cA + kstep, voffA); PG8_STAGE(PG8_SB(1, 1), cB + hstepB + kstep, voffB);
    PG8_WAIT_V(6); PG8_BAR;
    for (;;) {
        const bool has_next = S.next(ui + 1, nxt);
        const char* nA = has_next ? PG8_APTR(nxt) : cA; const char* nB = has_next ? PG8_BPTR(nxt) : cB;
        for (int t = 0; t < nt; t += 2) {
            const bool last = (t == nt - 2);
            const char* a1 = cA + (size_t)(t + 1) * kstep;
            const char* a2 = last ? nA : cA + (size_t)(t + 2) * kstep; const char* b2 = last ? nB : cB + (size_t)(t + 2) * kstep;
            const char* a3 = a2 + kstep; const char* b3 = b2 + kstep;
            PG8_LDB(B0, 0, 0); PG8_SCHED; PG8_LDA(At, 0, 0); PG8_STAGE(PG8_SA(1, 1), a1 + hstepA, voffA);
            PG8_WAIT_L(8); PG8_BAR; PG8_WAIT_L(0); PG8_MMA(0, 0, At, B0); PG8_BAR; PG8_SCHED;
            PG8_LDB(B1, 0, 1); PG8_STAGE(PG8_SB(0, 0), b2, voffB);
            PG8_BAR; PG8_WAIT_L(0); PG8_MMA(0, 1, At, B1); PG8_BAR;
            PG8_LDA(At, 0, 1); PG8_STAGE(PG8_SA(0, 0), a2, voffA);
            PG8_BAR; PG8_WAIT_L(0); PG8_MMA(1, 0, At, B0); PG8_BAR; PG8_SCHED;
            PG8_STAGE(PG8_SB(0, 1), b2 + hstepB, voffB);
            PG8_WAIT_V(6); PG8_BAR; PG8_MMA(1, 1, At, B1); PG8_BAR;
            PG8_LDB(B0, 1, 0); PG8_SCHED; PG8_LDA(At, 1, 0); PG8_STAGE(PG8_SA(0, 1), a2 + hstepA, voffA);
            PG8_WAIT_L(8); PG8_BAR; PG8_WAIT_L(0); PG8_MMA(0, 0, At, B0); PG8_BAR; PG8_SCHED;
            PG8_LDB(B1, 1, 1); PG8_STAGE(PG8_SB(1, 0), b3, voffB);
            PG8_BAR; PG8_WAIT_L(0); PG8_MMA(0, 1, At, B1); PG8_BAR;
            PG8_LDA(At, 1, 1); PG8_STAGE(PG8_SA(1, 0), a3, voffA);
            PG8_BAR; PG8_WAIT_L(0); PG8_MMA(1, 0, At, B0); PG8_BAR; PG8_SCHED;
            PG8_STAGE(PG8_SB(1, 1), b3 + hstepB, voffB);
            PG8_WAIT_V(6); PG8_BAR; PG8_MMA(1, 1, At, B1); PG8_BAR;
        }
        E(acc, cur, wr, wc, fr, fq);
        if (!has_next) break;
#pragma unroll
        for (int a = 0; a < 2; ++a)
#pragma unroll
            for (int b = 0; b < 2; ++b)
#pragma unroll
                for (int m = 0; m < 4; ++m)
#pragma unroll
                    for (int n = 0; n < 2; ++n) acc[a][b][m][n] = (f32x4){0.f, 0.f, 0.f, 0.f};
        cur = nxt; cA = nA; cB = nB; ++ui; nt = cur.nt;
    }
    PG8_WAIT_V(0);
    if (wr == 0) PG8_BAR;
    PG8_BAR;
#undef PG8_APTR
#undef PG8_BPTR
#undef PG8_SA
#undef PG8_SB
#undef PG8_STAGE
#undef PG8_LDA
#undef PG8_LDB
#undef PG8_MMA
#undef PG8_WAIT_V
#undef PG8_WAIT_L
#undef PG8_BAR
#undef PG8_SCHED
}
}
namespace pg8 {
template <int ACT  > struct EpiBf16 {
    static constexpr bool PERM = true;
    bf16_t* O; int ldc;
    __device__ __forceinline__ void operator()(const f32x4 (&acc)[2][2][4][2], const Unit& u, int wr, int wc, int fr, int fq) const {
        const int row0 = u.pm * BM + wr * 64 + fr;
        int colt = u.pn * BM; if (ACT == 2) colt = (u.pn >> 2) * 2048 + (u.pn & 3) * 256;
        const int col0 = colt + wc * 32 + 8 * fq;
#pragma unroll
        for (int ai = 0; ai < 2; ++ai)
#pragma unroll
            for (int m = 0; m < 4; ++m) { bf16_t* rowp = O + (size_t)(row0 + ai * HALF + m * 16) * ldc + col0;
#pragma unroll
                for (int bj = 0; bj < 2; ++bj) { f32x4 v0 = acc[ai][bj][m][0], v1 = acc[ai][bj][m][1];
                    if (ACT == 1) {
#pragma unroll
                        for (int j = 0; j < 4; ++j) { const float a = fmaxf(v0[j], 0.f), b = fmaxf(v1[j], 0.f); v0[j] = a * a; v1[j] = b * b; } }
                    if (ACT == 2) {
#pragma unroll
                        for (int j = 0; j < 4; ++j) { v0[j] = sigmoidf_(v0[j]); v1[j] = sigmoidf_(v1[j]); } }
                    u32x4 w; w.x = cvt_pk_bf16(v0[0], v0[1]); w.y = cvt_pk_bf16(v0[2], v0[3]); w.z = cvt_pk_bf16(v1[0], v1[1]); w.w = cvt_pk_bf16(v1[2], v1[3]);
                    *(u32x4*)(rowp + bj * HALF) = w; } }
    }
};
struct EpiGateU8 {
    static constexpr bool PERM = true;
    unsigned char* SG8; unsigned char* SGS;
    __device__ __forceinline__ void operator()(const f32x4 (&acc)[2][2][4][2], const Unit& u, int wr, int wc, int fr, int fq) const {
        const int row0 = u.pm * BM + wr * 64 + fr, col0 = u.pn * BM + wc * 32 + 8 * fq; const bool smp = u.pm >= 64;
#pragma unroll
        for (int ai = 0; ai < 2; ++ai)
#pragma unroll
            for (int m = 0; m < 4; ++m) { const size_t rr = (size_t)(row0 + ai * HALF + m * 16); unsigned char* rowp = smp ? SGS + (rr - NP) * 3072 + col0 : SG8 + rr * (PW * 2) + col0;
#pragma unroll
                for (int bj = 0; bj < 2; ++bj) { const f32x4 v0 = acc[ai][bj][m][0], v1 = acc[ai][bj][m][1]; unsigned q[8];
#pragma unroll
                    for (int j = 0; j < 4; ++j) { q[j] = (unsigned)(sigmoidf_(v0[j]) * 255.0f + 0.5f); q[4 + j] = (unsigned)(sigmoidf_(v1[j]) * 255.0f + 0.5f); }
                    u32x2 w; w.x = q[0] | (q[1] << 8) | (q[2] << 16) | (q[3] << 24); w.y = q[4] | (q[5] << 8) | (q[6] << 16) | (q[7] << 24);
                    *(u32x2*)(rowp + bj * HALF) = w; } }
    }
};
struct EpiMerge {
    static constexpr bool PERM = true;
    const unsigned char* SG8; const unsigned char* SGS; bf16_t* MG; bf16_t* P;
    __device__ __forceinline__ void operator()(const f32x4 (&acc)[2][2][4][2], const Unit& u, int wr, int wc, int fr, int fq) const {
        const int row0 = u.pm * BM + wr * 64 + fr, col0 = u.pn * BM + wc * 32 + 8 * fq; const bool smp = u.pm >= 64;
        const float S8 = 1.0f / 255.0f;
#pragma unroll
        for (int ai = 0; ai < 2; ++ai) {
            u32x2 sgv[4][2]; u32x4 pvv[4][2];
#pragma unroll
            for (int m = 0; m < 4; ++m) { const size_t r = (size_t)(row0 + ai * HALF + m * 16);
#pragma unroll
                for (int bj = 0; bj < 2; ++bj) { const int c = col0 + bj * HALF;
                    sgv[m][bj] = *(const u32x2*)(smp ? SGS + (r - NP) * 3072 + u.z * 1024 + c : SG8 + r * (PW * 2) + u.z * 1024 + c);
                    pvv[m][bj] = (u32x4){0u, 0u, 0u, 0u}; if (u.z > 0 && u.kind == 0) pvv[m][bj] = *(const u32x4*)(MG + r * DM + c); } }
#pragma unroll
            for (int m = 0; m < 4; ++m) { const size_t r = (size_t)(row0 + ai * HALF + m * 16);
#pragma unroll
                for (int bj = 0; bj < 2; ++bj) { const int c = col0 + bj * HALF; const u32x2 sg = sgv[m][bj]; const u32x4 pv = pvv[m][bj];
                    const f32x4 v0 = acc[ai][bj][m][0], v1 = acc[ai][bj][m][1];
                    float o[8];
                    o[0] = bflo(pv.x) + (float)(sg.x & 255u) * S8 * v0[0]; o[1] = bfhi(pv.x) + (float)((sg.x >> 8) & 255u) * S8 * v0[1]; o[2] = bflo(pv.y) + (float)((sg.x >> 16) & 255u) * S8 * v0[2]; o[3] = bfhi(pv.y) + (float)(sg.x >> 24) * S8 * v0[3];
                    o[4] = bflo(pv.z) + (float)(sg.y & 255u) * S8 * v1[0]; o[5] = bfhi(pv.z) + (float)((sg.y >> 8) & 255u) * S8 * v1[1]; o[6] = bflo(pv.w) + (float)((sg.y >> 16) & 255u) * S8 * v1[2]; o[7] = bfhi(pv.w) + (float)(sg.y >> 24) * S8 * v1[3];
                    u32x4 w; w.x = cvt_pk_bf16(o[0], o[1]); w.y = cvt_pk_bf16(o[2], o[3]); w.z = cvt_pk_bf16(o[4], o[5]); w.w = cvt_pk_bf16(o[6], o[7]);
                    if (u.kind == 2) *(u32x4*)(P + (size_t)u.z * (512 * 1024) + (r - NP) * DM + c) = w; else *(u32x4*)(MG + r * DM + c) = w; } }
        }
    }
};
struct EpiRes {
    static constexpr bool PERM = true;
    const bf16_t* R; bf16_t* T; float* TS;
    __device__ __forceinline__ void operator()(const f32x4 (&acc)[2][2][4][2], const Unit& u, int wr, int wc, int fr, int fq) const {
        const int row0 = u.pm * BM + wr * 64 + fr, col0 = u.pn * BM + wc * 32 + 8 * fq;
        const float al = (u.kind == 0 || u.z == 0) ? ALPHA : 0.f;
        u32x4 rv[8][2];
#pragma unroll
        for (int g = 0; g < 8; ++g) { const size_t off = (size_t)(row0 + (g >> 2) * HALF + (g & 3) * 16) * DM + col0;
#pragma unroll
            for (int bj = 0; bj < 2; ++bj) rv[g][bj] = *(const u32x4*)(R + off + bj * HALF); }
#pragma unroll
        for (int g = 0; g < 8; ++g) { const int ai = g >> 2, m = g & 3; const size_t off = (size_t)(row0 + ai * HALF + m * 16) * DM + col0;
#pragma unroll
            for (int bj = 0; bj < 2; ++bj) { const f32x4 a0 = acc[ai][bj][m][0], a1 = acc[ai][bj][m][1]; const u32x4 r4 = rv[g][bj];
                f32x4 o0, o1;
                o0[0] = al * bflo(r4.x) + a0[0]; o0[1] = al * bfhi(r4.x) + a0[1]; o0[2] = al * bflo(r4.y) + a0[2]; o0[3] = al * bfhi(r4.y) + a0[3];
                o1[0] = al * bflo(r4.z) + a1[0]; o1[1] = al * bfhi(r4.z) + a1[1]; o1[2] = al * bflo(r4.w) + a1[2]; o1[3] = al * bfhi(r4.w) + a1[3];
                if (u.kind == 1) { float* tp = TS + (size_t)u.z * (512 * 1024) - (size_t)NP * DM + off + bj * HALF; *(f32x4*)tp = o0; *(f32x4*)(tp + 4) = o1; }
                else { u32x4 w; w.x = cvt_pk_bf16(o0[0], o0[1]); w.y = cvt_pk_bf16(o0[2], o0[3]); w.z = cvt_pk_bf16(o1[0], o1[1]); w.w = cvt_pk_bf16(o1[2], o1[3]); *(u32x4*)(T + off + bj * HALF) = w; } } }
    }
};
}
__device__ const double INVF_TAB[64] = {1.0, 0.8639884421904872, 0.7464760282387446, 0.6449466718349793, 0.5572264607350911, 0.4814372300171723, 0.4159562095110165, 0.35938136364028433, 0.3105013285433559, 0.26826956374857486, 0.2317818064466077, 0.20025680531542636, 0.1730195682307726, 0.14948690978871287, 0.12915496453195024, 0.11158839852149276, 0.09641107502718904, 0.083298055951679, 0.07196855883385066, 0.062180004100288046, 0.05372280579965271, 0.04641588408923615, 0.04010278807514057, 0.03464834599094895, 0.029935770990762976, 0.02586416058779556, 0.022346336198178787, 0.019306976531752063, 0.016681004863249332, 0.01441219565322053, 0.012451970684591487, 0.010758358938547867, 0.009295095387898274, 0.008030855121976314, 0.006938566125329044, 0.005994841040503793, 0.005179473460621423, 0.004475005283380656, 0.0038663529099118386, 0.003340484284901384, 0.002886139862987199, 0.0024935915269452234, 0.002154434295785405, 0.0018614063629509262, 0.0016082336113996364, 0.0013894952764291722, 0.0012005078799085084, 0.0010372249507937684, 0.0008961503848114063, 0.0007742635882245655, 0.0006689548029112771, 0.0005779692279785651, 0.0004993587414820355, 0.0004314401885488794, 0.00037275934279762493, 0.00032205976942079685, 0.0002782559232477479, 0.00024040990578147253, 0.00020771138354670873, 0.00017946023777449892, 0.00015505157392992585, 0.00013396277011711087, 0.00011574228705063282, 0.0001};
struct TileDesc { const float* src; bf16_t* dst; int ldsrc, ldd; };
__device__ __forceinline__ TileDesc prep_tile(const DP& p, int j) {
    TileDesc d;
    if (j < 4608) { const int l = j / 2304, rem = j % 2304, kt = rem & 15, nt = rem >> 4; const int n0 = nt * 64;
        const int c0 = n0 < 2048 ? n0 : (n0 < 6144 ? n0 + 8 : n0 + 16);
        d.src = p.in(I_WIN) + (size_t)l * 1024 * 9232 + (size_t)(kt * 64) * 9232 + c0; d.ldsrc = 9232; d.dst = (bf16_t*)(p.ws() + WS_WIN) + (size_t)l * 9216 * 1024 + (size_t)n0 * 1024 + kt * 64; d.ldd = 1024; }
    else if (j < 5376) { const int idx = j - 4608, l = idx / 384, rem = idx % 384, b = rem / 128, rem2 = rem % 128, kt = rem2 & 7, nt = rem2 >> 3;
        d.src = p.in(I_WBA + b) + (size_t)l * 512 * 1024 + (size_t)(kt * 64) * 1024 + nt * 64; d.ldsrc = 1024; d.dst = (bf16_t*)(p.ws() + WS_WBR) + (size_t)(l * 3 + b) * 1024 * 512 + (size_t)(nt * 64) * 512 + kt * 64; d.ldd = 512; }
    else if (j < 5888) { const int idx = j - 5376, l = idx / 256, rem = idx % 256, kt = rem & 15, nt = rem >> 4;
        d.src = p.in(I_WOUT) + (size_t)l * 1024 * 1024 + (size_t)(kt * 64) * 1024 + nt * 64; d.ldsrc = 1024; d.dst = (bf16_t*)(p.ws() + WS_WOUT) + (size_t)l * 1024 * 1024 + (size_t)(nt * 64) * 1024 + kt * 64; d.ldd = 1024; }
    else if (j < 7936) { const int idx = j - 5888, l = idx / 1024, rem = idx % 1024, kt = rem & 15, nt = rem >> 4;
        d.src = p.in(I_WFF1) + (size_t)l * 1024 * 4096 + (size_t)(kt * 64) * 4096 + nt * 64; d.ldsrc = 4096; d.dst = (bf16_t*)(p.ws() + WS_WFF1) + (size_t)l * 4096 * 1024 + (size_t)(nt * 64) * 1024 + kt * 64; d.ldd = 1024; }
    else { const int idx = j - 7936, l = idx / 1024, rem = idx % 1024, kt = rem & 63, nt = rem >> 6;
        d.src = p.in(I_WFF2) + (size_t)l * 4096 * 1024 + (size_t)(kt * 64) * 1024 + nt * 64; d.ldsrc = 1024; d.dst = (bf16_t*)(p.ws() + WS_WFF2) + (size_t)l * 1024 * 4096 + (size_t)(nt * 64) * 4096 + kt * 64; d.ldd = 4096; }
    return d;
}
__device__ __forceinline__ int layer_tile(int l, int i) {
    if (i < 2304) return l * 2304 + i;
    if (i < 2688) return 4608 + l * 384 + (i - 2304);
    if (i < 2944) return 5376 + l * 256 + (i - 2688);
    if (i < 3968) return 5888 + l * 1024 + (i - 2944);
    return 7936 + l * 1024 + (i - 3968);
}
__device__ void prep_one_tile(const DP& p, int j, LAS unsigned char* lds) {
    lds = launder_lds(lds);
    LAS float* b = (LAS float*)lds; const int tid = my_tid();
    const TileDesc d = prep_tile(p, j);
    float cur[8];
#pragma unroll
    for (int i = 0; i < 8; ++i) { const int idx = tid + i * 512, r = idx >> 6, c = idx & 63; cur[i] = d.src[(size_t)r * d.ldsrc + c]; }
    __syncthreads();
#pragma unroll
    for (int i = 0; i < 8; ++i) { const int idx = tid + i * 512, r = idx >> 6, c = idx & 63; b[r * 65 + c] = cur[i]; }
    __syncthreads();
#pragma unroll
    for (int i = 0; i < 4; ++i) { const int idx = tid + i * 512, n = idx >> 5, kp = idx & 31;
        *(unsigned*)(d.dst + (size_t)n * d.ldd + 2 * kp) = cvt_pk_bf16(b[(2 * kp) * 65 + n], b[(2 * kp + 1) * 65 + n]); }
}
__device__ void phase_prep(const DP& p, LAS unsigned char* lds) {
    lds = launder_lds(lds);
    LAS float* buf = (LAS float*)lds;
    const int G = gridDim.x, tid0 = my_tid(), bid0 = my_bid();
    const int tid = tid0;
    float cur[8]; TileDesc dc, dn; int par = 0;
    if (bid0 < 4992) { dc = prep_tile(p, layer_tile(0, bid0));
#pragma unroll
        for (int i = 0; i < 8; ++i) { const int idx = tid + i * 512, r = idx >> 6, c = idx & 63; cur[i] = dc.src[(size_t)r * dc.ldsrc + c]; } }
    for (int j = bid0; j < 4992; j += G) {
        float nxt[8]; const bool hn = j + G < 4992;
        if (hn) { dn = prep_tile(p, layer_tile(0, j + G));
#pragma unroll
            for (int i = 0; i < 8; ++i) { const int idx = tid + i * 512, r = idx >> 6, c = idx & 63; nxt[i] = dn.src[(size_t)r * dn.ldsrc + c]; } }
        LAS float* b = buf + par * (64 * 65);
#pragma unroll
        for (int i = 0; i < 8; ++i) { const int idx = tid + i * 512, r = idx >> 6, c = idx & 63; b[r * 65 + c] = cur[i]; }
        __syncthreads();
#pragma unroll
        for (int i = 0; i < 4; ++i) { const int idx = tid + i * 512, n = idx >> 5, kp = idx & 31;
            *(unsigned*)(dc.dst + (size_t)n * dc.ldd + 2 * kp) = cvt_pk_bf16(b[(2 * kp) * 65 + n], b[(2 * kp + 1) * 65 + n]); }
        if (hn) {
#pragma unroll
            for (int i = 0; i < 8; ++i) cur[i] = nxt[i];
            dc = dn; }
        par ^= 1;
    }
    __syncthreads();
    const size_t gtid = (size_t)bid0 * 512 + tid0, gsz = (size_t)G * 512;
    bf16_t* X = (bf16_t*)(p.ws() + WS_X);
    for (size_t i0 = gtid; i0 < (size_t)NTOK * DM / 8; i0 += 4 * gsz) {
        f32x4 a[4], b[4];
#pragma unroll
        for (int u = 0; u < 4; ++u) { const size_t i = i0 + u * gsz; const size_t e = (i < (size_t)NTOK * DM / 8 ? i : i0) * 8; const float* s = e < (size_t)NP * DM ? p.in(I_XP) + e : p.in(I_XS) + (e - (size_t)NP * DM);
            a[u] = *(const f32x4*)s; b[u] = *(const f32x4*)(s + 4); }
#pragma unroll
        for (int u = 0; u < 4; ++u) { const size_t i = i0 + u * gsz;
            if (i < (size_t)NTOK * DM / 8) { u32x4 w; w.x = cvt_pk_bf16(a[u][0], a[u][1]); w.y = cvt_pk_bf16(a[u][2], a[u][3]); w.z = cvt_pk_bf16(b[u][0], b[u][1]); w.w = cvt_pk_bf16(b[u][2], b[u][3]);
                *(u32x4*)(X + i * 8) = w; } } }
    float* rope = (float*)(p.ws() + WS_ROPE);
    for (size_t i = gtid; i < (size_t)2052 * 64; i += gsz) { const int pi = (int)(i >> 6), fi = (int)(i & 63);
        const double pos = pi < 2048 ? (double)pi : (double)(16384 + pi - 2048);
        const double ang = pos * INVF_TAB[fi];
        const double rr = ang - rint(ang * 0.15915494309189535) * 6.283185307179586;
        const float sn = __sinf((float)rr), cs = __cosf((float)rr);
        rope[(size_t)pi * 128 + fi] = cs; rope[(size_t)pi * 128 + 64 + fi] = sn; }
}

__device__ void phase_small(const DP& p, int l, LAS unsigned char* lds) {
    lds = launder_lds(lds);
    LAS float* wl = (LAS float*)lds;
    const int tid = my_tid(), lane = tid & 63, wave = tid >> 6, bid0 = my_bid();
    const float* win = p.in(I_WIN) + (size_t)l * 1024 * 9232;
    __syncthreads();
    {
#pragma unroll
        for (int i0 = 0; i0 < 32; i0 += 8) { float tmp[8];
#pragma unroll
            for (int i = 0; i < 8; ++i) { const int idx = tid + (i0 + i) * 512, k = idx >> 4, j = idx & 15; tmp[i] = win[(size_t)k * 9232 + (j < 8 ? 2048 + j : 6152 + (j - 8))]; }
#pragma unroll
            for (int i = 0; i < 8; ++i) { const int idx = tid + (i0 + i) * 512, k = idx >> 4, j = idx & 15; wl[j * 1024 + k] = tmp[i]; } } }
    __syncthreads();
    const bf16_t* X = (const bf16_t*)(p.ws() + WS_X); float* SM = (float*)(p.ws() + WS_SMALL);
    const int rstep = gridDim.x * 8; int r = bid0 * 8 + wave;
    u32x4 na = (u32x4){0u, 0u, 0u, 0u}, nb = na;
    if (r < NTOK) { na = *(const u32x4*)(X + (size_t)r * DM + lane * 16); nb = *(const u32x4*)(X + (size_t)r * DM + lane * 16 + 8); }
    for (; r < NTOK; r += rstep) {
        const u32x4 a = na, b = nb;
        if (r + rstep < NTOK) { na = *(const u32x4*)(X + (size_t)(r + rstep) * DM + lane * 16); nb = *(const u32x4*)(X + (size_t)(r + rstep) * DM + lane * 16 + 8); }
        float x[16] = {bflo(a.x), bfhi(a.x), bflo(a.y), bfhi(a.y), bflo(a.z), bfhi(a.z), bflo(a.w), bfhi(a.w), bflo(b.x), bfhi(b.x), bflo(b.y), bfhi(b.y), bflo(b.z), bfhi(b.z), bflo(b.w), bfhi(b.w)};
        float mine = 0.f;
#pragma unroll 1
        for (int jg = 0; jg < 4; ++jg) { float s4[4];
#pragma unroll
            for (int jj = 0; jj < 4; ++jj) { const int j = jg * 4 + jj; float acc = 0.f;
#pragma unroll
                for (int q = 0; q < 4; ++q) { const f32x4 w = *(const LAS f32x4*)(wl + j * 1024 + lane * 16 + q * 4); acc += x[q * 4] * w[0] + x[q * 4 + 1] * w[1] + x[q * 4 + 2] * w[2] + x[q * 4 + 3] * w[3]; }
                s4[jj] = acc; }
#pragma unroll
            for (int o = 32; o >= 1; o >>= 1) {
#pragma unroll
                for (int jj = 0; jj < 4; ++jj) s4[jj] += __shfl_xor(s4[jj], o); }
#pragma unroll
            for (int jj = 0; jj < 4; ++jj) if (lane == jg * 4 + jj) mine = s4[jj]; }
        if (lane < 16) SM[(size_t)r * 16 + lane] = mine;
    }
    __syncthreads();
}

__device__ __forceinline__ void ln_finish(const f32x4 (&v)[4], int r, int lane, const f32x4 (&gg4)[4], const f32x4 (&bb4)[4], bf16_t* __restrict__ O, float* __restrict__ yp, float* __restrict__ ys) {
    float s = 0.f;
#pragma unroll
    for (int i = 0; i < 4; ++i) s += (v[i][0] + v[i][1]) + (v[i][2] + v[i][3]);
#pragma unroll
    for (int o = 32; o >= 1; o >>= 1) s += __shfl_xor(s, o);
    const float mu = s * (1.0f / 1024.0f); float q = 0.f;
#pragma unroll
    for (int i = 0; i < 4; ++i) { const f32x4 d = v[i] - mu; q += (d[0] * d[0] + d[1] * d[1]) + (d[2] * d[2] + d[3] * d[3]); }
#pragma unroll
    for (int o = 32; o >= 1; o >>= 1) q += __shfl_xor(q, o);
    const float rstd = rsqrtf(q * (1.0f / 1024.0f) + 1e-5f);
    float* y = yp ? (r < NP ? yp + (size_t)r * DM : ys + (size_t)(r - NP) * DM) : nullptr;
#pragma unroll
    for (int i = 0; i < 4; ++i) { const int c = i * 256 + lane * 4; const f32x4 gg = gg4[i], bb = bb4[i];
        const f32x4 o = (v[i] - mu) * rstd * gg + bb;
        u32x2 w; w.x = cvt_pk_bf16(o[0], o[1]); w.y = cvt_pk_bf16(o[2], o[3]); *(u32x2*)(O + (size_t)r * DM + c) = w;
        if (y) *(f32x4*)(y + c) = o; }
}
__device__ void phase_ln(const bf16_t* __restrict__ T, const float* __restrict__ TS, int npieces, const float* __restrict__ g, const float* __restrict__ bta, bf16_t* __restrict__ O, float* __restrict__ yp, float* __restrict__ ys) {
    const int tid0 = my_tid(), lane = tid0 & 63, wave = tid0 >> 6, bid0 = my_bid();
    const int stride = gridDim.x * 8;
    const int nbf = npieces == 0 ? NTOK : NP;
    f32x4 gg4[4], bb4[4];
#pragma unroll
    for (int i = 0; i < 4; ++i) { gg4[i] = *(const f32x4*)(g + i * 256 + lane * 4); bb4[i] = *(const f32x4*)(bta + i * 256 + lane * 4); }
    int r0 = bid0 * 8 + wave;
    for (; r0 + 3 * stride < nbf; r0 += 4 * stride) {
        u32x2 hh[4][4];
#pragma unroll
        for (int k = 0; k < 4; ++k)
#pragma unroll
            for (int i = 0; i < 4; ++i) hh[k][i] = *(const u32x2*)(T + (size_t)(r0 + k * stride) * DM + i * 256 + lane * 4);
#pragma unroll
        for (int k = 0; k < 4; ++k) { f32x4 vv[4];
#pragma unroll
            for (int i = 0; i < 4; ++i) vv[i] = (f32x4){bflo(hh[k][i].x), bfhi(hh[k][i].x), bflo(hh[k][i].y), bfhi(hh[k][i].y)};
            ln_finish(vv, r0 + k * stride, lane, gg4, bb4, O, yp, ys); }
    }
    for (; r0 < nbf; r0 += stride) {
        f32x4 vv[4];
#pragma unroll
        for (int i = 0; i < 4; ++i) { const u32x2 h = *(const u32x2*)(T + (size_t)r0 * DM + i * 256 + lane * 4); vv[i] = (f32x4){bflo(h.x), bfhi(h.x), bflo(h.y), bfhi(h.y)}; }
        ln_finish(vv, r0, lane, gg4, bb4, O, yp, ys);
    }
    if (npieces > 0) for (int r = NP + bid0 * 8 + wave; r < NTOK; r += stride) {
        f32x4 v[4]; const float* tp = TS + (size_t)(r - NP) * DM;
#pragma unroll
        for (int i = 0; i < 4; ++i) v[i] = *(const f32x4*)(tp + i * 256 + lane * 4);
        for (int z0 = 1; z0 < npieces; z0 += 4) { f32x4 tmp[4][4];
#pragma unroll
            for (int zz = 0; zz < 4; ++zz) { const int z = (z0 + zz < npieces) ? z0 + zz : z0;
#pragma unroll
                for (int i = 0; i < 4; ++i) tmp[zz][i] = *(const f32x4*)(tp + (size_t)z * (512 * 1024) + i * 256 + lane * 4); }
#pragma unroll
            for (int zz = 0; zz < 4; ++zz) if (z0 + zz < npieces) {
#pragma unroll
                for (int i = 0; i < 4; ++i) v[i] += tmp[zz][i]; } }
        ln_finish(v, r, lane, gg4, bb4, O, yp, ys);
    }
}
template <int MIX  >
__device__ void rec_item(const DP& p, int l, bool prompt, int b, int h, LAS unsigned char* lds) {
    lds = launder_lds(lds);
    int tid_l = threadIdx.x; asm volatile("" : "+v"(tid_l));
    const int tid = tid_l, lane = tid & 63, wave = tid >> 6;
    const int v = tid & 127, kg = tid >> 7, k0 = kg * 32;
    const int T = prompt ? SEQ : 4, NBt = prompt ? NB : NDB;
    const size_t row0 = prompt ? (size_t)b * SEQ : (size_t)NP + (size_t)b * 4;
    const int pi0 = prompt ? 0 : 2048;
    bf16_t* PROJ = (bf16_t*)(p.ws() + WS_PROJ); const float* SM = (const float*)(p.ws() + WS_SMALL); const float* rope = (const float*)(p.ws() + WS_ROPE);
    LAS float* vec = (LAS float*)lds;
    LAS float* red = vec + 768;
    LAS float* part = red + 1024;
    LAS float* partS = part + 16;
    LAS float* partN = partS + 4;
    const size_t sidx = ((size_t)(l * NBt + b) * 4 + h);
    float S[32];
    {
        const float* st_in = prompt ? nullptr : p.in(MIX == 0 ? I_SS : (MIX == 1 ? I_SR : I_SC)) + sidx * 16384;
#pragma unroll
        for (int i = 0; i < 32; ++i) S[i] = st_in ? st_in[(k0 + i) * 128 + v] : 0.f;
    }
    float nn = 0.f, mm = 0.f;
    if (MIX == 2 && !prompt) { if (tid < 128) nn = p.in(I_SN)[sidx * 128 + tid]; mm = p.in(I_SM)[sidx]; }
    const int which = tid >> 7, cc = tid & 127;
    const int colq = MIX * 2048 + h * 128, colg = colq + 1536;
    const int gcol = which * 512 + h * 128 + cc;
    float cw0 = 0.f, cw1 = 0.f, cw2 = 0.f, cw3 = 0.f, x0 = 0.f, x1 = 0.f, x2 = 0.f;
    if (MIX == 0 && tid < 384) {
        const float* cwp = p.in(I_CONVW) + (size_t)l * 4 * 1536 + gcol; cw0 = cwp[0]; cw1 = cwp[1536]; cw2 = cwp[2 * 1536]; cw3 = cwp[3 * 1536];
        if (!prompt) { const float* cb = p.in(I_SCONV) + (size_t)(l * NDB + b) * 3 * 1536 + gcol; x0 = cb[0]; x1 = cb[1536]; x2 = cb[2 * 1536]; }
    }
    float Aexp = 0.f, dtb = 0.f, normw = 1.f, gamma = 0.f, ib = 0.f, fb = 0.f;
    if (MIX == 0) { Aexp = __expf(p.in(I_ALOG)[l * 4 + h]); dtb = p.in(I_DTB)[l * 4 + h]; normw = p.in(I_DNW)[l * 128 + v]; }
    if (MIX == 1) gamma = 1.0f - exp2f(-5.0f - (float)h);
    if (MIX == 2) { ib = p.in(I_IB)[l * 4 + h]; fb = p.in(I_FB)[l * 4 + h]; normw = p.in(I_MLW)[l * 512 + h * 128 + v]; }
    bf16_t pa = 0, pb = 0, pg = 0; float s0 = 0.f, s1 = 0.f;
#define REC_PREFETCH(tt) do { const size_t r_ = row0 + (tt); const bf16_t* pr = PROJ + r_ * PW; \
        if (tid < 384) { \
            if (MIX == 0) pa = pr[gcol]; \
            else if (MIX == 1 && which < 2) { const int i_ = cc & 63; pa = pr[colq + which * 512 + i_]; pb = pr[colq + which * 512 + i_ + 64]; } \
            else pa = pr[colq + which * 512 + cc]; \
        } \
        if (tid < 128) pg = pr[colg + v]; \
        if (MIX == 0) { s0 = SM[r_ * 16 + h]; s1 = SM[r_ * 16 + 4 + h]; } \
        if (MIX == 2) { s0 = SM[r_ * 16 + 8 + h]; s1 = SM[r_ * 16 + 12 + h]; } } while (0)
    REC_PREFETCH(0);
    __syncthreads();
    for (int t = 0; t < T; ++t) {
        const int par = t & 1; const size_t r = row0 + t;
        const bf16_t ca = pa, cb = pb, cgate = pg; const float cs0 = s0, cs1 = s1;
        if (t + 1 < T) REC_PREFETCH(t + 1);
        if (tid < 384) {
            float val;
            if (MIX == 0) { const float xn = bf2f(ca); const float c = x0 * cw0 + x1 * cw1 + x2 * cw2 + xn * cw3; x0 = x1; x1 = x2; x2 = xn; val = siluf_(c);
                if (which < 2) { float q = val * val;
#pragma unroll
                    for (int o = 32; o >= 1; o >>= 1) q += __shfl_xor(q, o);
                    if (lane == 0) part[par * 8 + wave] = q; } }
            else if (MIX == 1 && which < 2) { const int i = cc & 63; const float xa = bf2f(ca), xb = bf2f(cb); const float cs = rope[(size_t)(pi0 + t) * 128 + i], sn = rope[(size_t)(pi0 + t) * 128 + 64 + i];
                val = cc < 64 ? xa * cs - xb * sn : xa * sn + xb * cs; if (which == 1) val *= DKS; }
            else { val = bf2f(ca); if (MIX != 0 && which == 1) val *= DKS; }
            vec[par * 384 + which * 128 + cc] = val;
        }
        __syncthreads();
        float a = 1.f, qs = 1.f, ks = 1.f, beta = 0.f, ipr = 1.f;
        if (MIX == 0) { beta = sigmoidf_(cs0); const float g = -Aexp * softplusf_(cs1 + dtb); a = __expf(g);
            qs = rsqrtf(part[par * 8 + 0] + part[par * 8 + 1] + 1e-6f) * DKS; ks = rsqrtf(part[par * 8 + 2] + part[par * 8 + 3] + 1e-6f); }
        if (MIX == 1) a = gamma;
        if (MIX == 2) { const float ip = cs0 + ib, fp = cs1 + fb; const float lf = logsigmoidf_(fp); const float mnew = fmaxf(lf + mm, ip); a = __expf(lf + mm - mnew); ipr = __expf(ip - mnew); mm = mnew; }
        const float vv = vec[par * 384 + 256 + v];
        float vnew;
        if (MIX == 0) { float pk = 0.f;
#pragma unroll
            for (int i = 0; i < 32; ++i) pk += vec[par * 384 + 128 + k0 + i] * S[i];
            red[kg * 128 + v] = pk * ks;
            __syncthreads();
            const float kS = (red[v] + red[128 + v]) + (red[256 + v] + red[384 + v]);
            vnew = beta * (vv - a * kS); }
        else if (MIX == 1) vnew = vv;
        else vnew = ipr * vv;
        float po = 0.f;
#pragma unroll
        for (int i = 0; i < 32; ++i) { S[i] = a * S[i] + (vec[par * 384 + 128 + k0 + i] * ks) * vnew; po += vec[par * 384 + k0 + i] * S[i]; }
        red[512 + kg * 128 + v] = po * qs;
        if (MIX == 2 && tid < 128) { nn = a * nn + ipr * vec[par * 384 + 128 + tid]; float qn = vec[par * 384 + tid] * nn;
#pragma unroll
            for (int o = 32; o >= 1; o >>= 1) qn += __shfl_xor(qn, o);
            if (lane == 0) partN[par * 2 + wave] = qn; }
        __syncthreads();
        float o = 0.f;
        if (tid < 128) { o = (red[512 + v] + red[512 + 128 + v]) + (red[512 + 256 + v] + red[512 + 384 + v]); float q = o * o;
#pragma unroll
            for (int of = 32; of >= 1; of >>= 1) q += __shfl_xor(q, of);
            if (lane == 0) partS[par * 2 + wave] = q; }
        __syncthreads();
        if (tid < 128) {
            const float ssq = partS[par * 2] + partS[par * 2 + 1]; const float gt = bf2f(cgate); float out;
            if (MIX == 2) { const float den = partN[par * 2] + partN[par * 2 + 1]; const float dd = fmaxf(fabsf(den), __expf(-mm)); const float hv = o / dd;
                out = hv * rsqrtf(ssq / (dd * dd) * (1.0f / 128.0f) + 1e-6f) * normw * sigmoidf_(gt); }
            else out = o * rsqrtf(ssq * (1.0f / 128.0f) + 1e-6f) * normw * siluf_(gt);
            PROJ[r * PW + colg + v] = f2bf(out);
        }
    }
    float* outp = p.out();
    {
        float* so = outp + (prompt ? (MIX == 0 ? O_PS : (MIX == 1 ? O_PR : O_PC)) : (MIX == 0 ? O_SS : (MIX == 1 ? O_SR : O_SC))) + sidx * 16384;
#pragma unroll
        for (int i = 0; i < 32; ++i) so[(k0 + i) * 128 + v] = S[i];
    }
    if (MIX == 0 && tid < 384) { float* co = outp + (prompt ? O_PCONV : O_SCONV) + (size_t)(l * NBt + b) * 3 * 1536 + gcol; co[0] = x0; co[1536] = x1; co[2 * 1536] = x2; }
    if (MIX == 2) { if (tid < 128) outp[(prompt ? O_PN : O_SN) + sidx * 128 + tid] = nn; if (tid == 0) outp[(prompt ? O_PM : O_SM) + sidx] = mm; }
    __syncthreads();
}
__device__ __forceinline__ bf16x8 ldfrag(const LAS bf16_t* base, int row, int ld, int k) { return *(const LAS bf16x8*)(base + row * ld + k); }
#define MFMA16(a, b, c) __builtin_amdgcn_mfma_f32_16x16x32_bf16((a), (b), (c), 0, 0, 0)

template <int MIX  >
__device__ void scan_item(const DP& p, int l, int b, int h, LAS unsigned char* lds) {
    lds = launder_lds(lds);
    const int tid = my_tid(), lane = tid & 63, wave = __builtin_amdgcn_readfirstlane(tid >> 6), l16 = lane & 15, quad = lane >> 4;
    bf16_t* PROJ = (bf16_t*)(p.ws() + WS_PROJ); const float* SM = (const float*)(p.ws() + WS_SMALL); const float* rope = (const float*)(p.ws() + WS_ROPE);
    LAS bf16_t* Qs = (LAS bf16_t*)(lds + 0); LAS bf16_t* Ks = (LAS bf16_t*)(lds + 17408); LAS bf16_t* KdT = (LAS bf16_t*)(lds + 34816);
    LAS bf16_t* VT = (LAS bf16_t*)(lds + 53248); LAS bf16_t* Ps = (LAS bf16_t*)(lds + 71680); LAS bf16_t* RT = (LAS bf16_t*)(lds + 80896);
    LAS float* red = (LAS float*)(lds + 115712); LAS float* GT = (LAS float*)(lds + 116224); LAS float* sdecs = (LAS float*)(lds + 118784);
    LAS float* nm = (LAS float*)(lds + 118800); LAS float* denl = (LAS float*)(lds + 119312);
    const int colq = MIX * 2048 + h * 128;
    const size_t row0 = (size_t)b * SEQ;
    const size_t sidx = (size_t)(l * NB + b) * 4 + h;
    __syncthreads();
    for (int i = tid; i < 128 * 136 / 2; i += 512) ((LAS unsigned*)RT)[i] = 0u;
    if (tid < 128) nm[tid] = 0.f;
    if (MIX == 1 && tid < 64) { const float lng = logf(1.0f - exp2f(-5.0f - (float)h));
#pragma unroll
        for (int par = 0; par < 2; ++par) { LAS float* G_ = GT + par * 320; G_[tid] = (float)tid * lng; G_[64 + tid] = -(float)tid * lng; G_[128 + tid] = __expf((float)(tid + 1) * lng); G_[192 + tid] = __expf((float)(63 - tid) * lng); G_[256 + tid] = 0.f; }
        if (tid == 0) { sdecs[0] = __expf(64.0f * lng); sdecs[1] = sdecs[0]; } }
    f32x4 Racc[8];
#pragma unroll
    for (int i = 0; i < 8; ++i) Racc[i] = (f32x4){0.f, 0.f, 0.f, 0.f};
    float mm = 0.f;
    const float ib = MIX == 2 ? p.in(I_IB)[l * 4 + h] : 0.f, fb = MIX == 2 ? p.in(I_FB)[l * 4 + h] : 0.f;
    const int lrow = tid & 63, cg = tid >> 6;
    u32x4 q1, q2, k1, k2, v1, v2; f32x4 rc0, rc1, rs0, rs1; float ipre = 0.f, fpre = 0.f; u32x2 gpre[4];
#define SC_LOAD(n_) do { const bf16_t* pr = PROJ + (row0 + (size_t)(n_) * 64 + lrow) * PW + colq; \
        q1 = *(const u32x4*)(pr + cg * 8); q2 = *(const u32x4*)(pr + 64 + cg * 8); k1 = *(const u32x4*)(pr + 512 + cg * 8); k2 = *(const u32x4*)(pr + 512 + 64 + cg * 8); \
        v1 = *(const u32x4*)(pr + 1024 + cg * 16); v2 = *(const u32x4*)(pr + 1024 + cg * 16 + 8); \
        if (MIX == 1) { const float* rp = rope + (size_t)((n_) * 64 + lrow) * 128 + cg * 8; rc0 = *(const f32x4*)rp; rc1 = *(const f32x4*)(rp + 4); rs0 = *(const f32x4*)(rp + 64); rs1 = *(const f32x4*)(rp + 68); } \
        if (MIX == 2 && wave == 0) { const size_t r_ = row0 + (size_t)(n_) * 64 + lane; ipre = SM[r_ * 16 + 8 + h]; fpre = SM[r_ * 16 + 12 + h]; } } while (0)
#define SC_GATES(n_) do { const float ip = ipre + ib, fp = fpre + fb; \
        float F = logsigmoidf_(fp); \
        _Pragma("unroll") for (int d = 1; d < 64; d <<= 1) { const float y = __shfl_up(F, d); if (lane >= d) F += y; } \
        const float a_ = ip - F; float cm = a_; \
        _Pragma("unroll") for (int d = 1; d < 64; d <<= 1) { const float y = __shfl_up(cm, d); if (lane >= d) cm = fmaxf(cm, y); } \
        const float mt = fmaxf(mm + F, F + cm); const float wst = __expf(mm + F - mt); \
        const float mnew = __shfl(mt, 63), Fl = __shfl(F, 63); \
        LAS float* G_ = GT + ((n_) & 1) * 320; G_[lane] = F - mt; G_[64 + lane] = a_; G_[128 + lane] = wst; G_[192 + lane] = __expf(a_ + Fl - mnew); G_[256 + lane] = __expf(-mt); \
        if (lane == 0) sdecs[(n_) & 1] = __expf(mm + Fl - mnew); mm = mnew; } while (0)
#define SC_STORE(n_) do { const int t_ = lrow; \
        float qa[8], qb[8], ka[8], kb[8]; \
        { const unsigned qw1[4] = {q1.x, q1.y, q1.z, q1.w}, qw2[4] = {q2.x, q2.y, q2.z, q2.w}, kw1[4] = {k1.x, k1.y, k1.z, k1.w}, kw2[4] = {k2.x, k2.y, k2.z, k2.w}; \
          _Pragma("unroll") for (int e = 0; e < 4; ++e) { qa[2 * e] = bflo(qw1[e]); qa[2 * e + 1] = bfhi(qw1[e]); qb[2 * e] = bflo(qw2[e]); qb[2 * e + 1] = bfhi(qw2[e]); \
              ka[2 * e] = bflo(kw1[e]); ka[2 * e + 1] = bfhi(kw1[e]); kb[2 * e] = bflo(kw2[e]); kb[2 * e + 1] = bfhi(kw2[e]); } } \
        float kdec; \
        if (MIX == 1) { const f32x4 c0 = rc0, c1 = rc1, s0 = rs0, s1 = rs1; \
            const float cs[8] = {c0[0], c0[1], c0[2], c0[3], c1[0], c1[1], c1[2], c1[3]}, sn[8] = {s0[0], s0[1], s0[2], s0[3], s1[0], s1[1], s1[2], s1[3]}; \
            _Pragma("unroll") for (int e = 0; e < 8; ++e) { const float x1 = qa[e], x2 = qb[e]; qa[e] = x1 * cs[e] - x2 * sn[e]; qb[e] = x1 * sn[e] + x2 * cs[e]; \
                const float y1 = ka[e], y2 = kb[e]; ka[e] = y1 * cs[e] - y2 * sn[e]; kb[e] = y1 * sn[e] + y2 * cs[e]; } \
            } \
        kdec = GT[((n_) & 1) * 320 + 192 + t_]; \
        _Pragma("unroll") for (int e = 0; e < 8; ++e) { ka[e] *= DKS; kb[e] *= DKS; } \
        { u32x4 w; w.x = cvt_pk_bf16(qa[0], qa[1]); w.y = cvt_pk_bf16(qa[2], qa[3]); w.z = cvt_pk_bf16(qa[4], qa[5]); w.w = cvt_pk_bf16(qa[6], qa[7]); *(LAS u32x4*)(Qs + t_ * 136 + cg * 8) = w; \
          w.x = cvt_pk_bf16(qb[0], qb[1]); w.y = cvt_pk_bf16(qb[2], qb[3]); w.z = cvt_pk_bf16(qb[4], qb[5]); w.w = cvt_pk_bf16(qb[6], qb[7]); *(LAS u32x4*)(Qs + t_ * 136 + 64 + cg * 8) = w; \
          w.x = cvt_pk_bf16(ka[0], ka[1]); w.y = cvt_pk_bf16(ka[2], ka[3]); w.z = cvt_pk_bf16(ka[4], ka[5]); w.w = cvt_pk_bf16(ka[6], ka[7]); *(LAS u32x4*)(Ks + t_ * 136 + cg * 8) = w; \
          w.x = cvt_pk_bf16(kb[0], kb[1]); w.y = cvt_pk_bf16(kb[2], kb[3]); w.z = cvt_pk_bf16(kb[4], kb[5]); w.w = cvt_pk_bf16(kb[6], kb[7]); *(LAS u32x4*)(Ks + t_ * 136 + 64 + cg * 8) = w; } \
        _Pragma("unroll") for (int e = 0; e < 8; ++e) { KdT[(cg * 8 + e) * 72 + t_] = f2bf(ka[e] * kdec); KdT[(64 + cg * 8 + e) * 72 + t_] = f2bf(kb[e] * kdec); } \
        { const unsigned vw[8] = {v1.x, v1.y, v1.z, v1.w, v2.x, v2.y, v2.z, v2.w}; \
          _Pragma("unroll") for (int e = 0; e < 8; ++e) { VT[(cg * 16 + 2 * e) * 72 + t_] = (bf16_t)(vw[e] & 0xffffu); VT[(cg * 16 + 2 * e + 1) * 72 + t_] = (bf16_t)(vw[e] >> 16); } } } while (0)

    SC_LOAD(0);
    if (MIX == 2 && wave == 0) SC_GATES(0);
    __syncthreads();
    SC_STORE(0);
    const int tm = wave >> 1, tnb = (wave & 1) * 2, tnb4 = (wave & 1) * 4;
    f32x4 nwv[4];
#pragma unroll
    for (int i = 0; i < 4; ++i) nwv[i] = MIX == 2 ? *(const f32x4*)(p.in(I_MLW) + l * 512 + h * 128 + 16 * (tnb4 + i) + 4 * quad) : (f32x4){1.f, 1.f, 1.f, 1.f};
    const int t = 16 * tm + l16;
    for (int n = 0; n < 32; ++n) {
        __syncthreads();
        if (n + 1 < 32) SC_LOAD(n + 1);
        { const bf16_t* gp_ = PROJ + (row0 + (size_t)n * 64 + t) * PW + colq + 1536;
#pragma unroll
          for (int i = 0; i < 4; ++i) gpre[i] = *(const u32x2*)(gp_ + 16 * (tnb4 + i) + 4 * quad); }
        const LAS float* G = GT + (n & 1) * 320;
        {
            f32x4 pacc[2] = {(f32x4){0.f, 0.f, 0.f, 0.f}, (f32x4){0.f, 0.f, 0.f, 0.f}};
#pragma unroll
            for (int kk = 0; kk < 4; ++kk) { const bf16x8 a = ldfrag(Qs, t, 136, kk * 32 + quad * 8);
#pragma unroll
                for (int i = 0; i < 2; ++i) { const bf16x8 bq = ldfrag(Ks, 16 * (tnb + i) + l16, 136, kk * 32 + quad * 8); pacc[i] = MFMA16(bq, a, pacc[i]); } }
            const float gt_ = G[t];
#pragma unroll
            for (int i = 0; i < 2; ++i) { const int s0 = 16 * (tnb + i) + 4 * quad; float w[4]; const f32x4 ga = *(const LAS f32x4*)(G + 64 + s0);
#pragma unroll
                for (int j = 0; j < 4; ++j) { const int s = s0 + j; float f;
                    f = __expf(gt_ + ga[j]);
                    w[j] = s <= t ? pacc[i][j] * f : 0.f; }
                u32x2 o; o.x = cvt_pk_bf16(w[0], w[1]); o.y = cvt_pk_bf16(w[2], w[3]); *(LAS u32x2*)(Ps + t * 72 + s0) = o; }
        }
        __syncthreads();
        f32x4 o2[4];
        {
            f32x4 o1[4];
#pragma unroll
            for (int i = 0; i < 4; ++i) { o1[i] = (f32x4){0.f, 0.f, 0.f, 0.f}; o2[i] = (f32x4){0.f, 0.f, 0.f, 0.f}; }
#pragma unroll
            for (int kk = 0; kk < 4; ++kk) { const bf16x8 a = ldfrag(Qs, t, 136, kk * 32 + quad * 8);
#pragma unroll
                for (int i = 0; i < 4; ++i) { const bf16x8 bq = ldfrag(RT, 16 * (tnb4 + i) + l16, 136, kk * 32 + quad * 8); o1[i] = MFMA16(bq, a, o1[i]); } }
#pragma unroll
            for (int kk = 0; kk < 2; ++kk) { const bf16x8 a = ldfrag(Ps, t, 72, kk * 32 + quad * 8);
#pragma unroll
                for (int i = 0; i < 4; ++i) { const bf16x8 bq = ldfrag(VT, 16 * (tnb4 + i) + l16, 72, kk * 32 + quad * 8); o2[i] = MFMA16(bq, a, o2[i]); } }
            const float qd = G[128 + t];
            float ssq = 0.f;
#pragma unroll
            for (int i = 0; i < 4; ++i) { o2[i] = o1[i] * qd + o2[i]; ssq += (o2[i][0] * o2[i][0] + o2[i][1] * o2[i][1]) + (o2[i][2] * o2[i][2] + o2[i][3] * o2[i][3]); }
            ssq += __shfl_xor(ssq, 16); ssq += __shfl_xor(ssq, 32);
            if (quad == 0) red[t * 2 + (wave & 1)] = ssq;
        }
        float nnew = 0.f;
        if (MIX == 2) {
            { const int tp = tid >> 3, part = tid & 7; float qn = 0.f, ds = 0.f;
              const u32x4 qa_ = *(const LAS u32x4*)(Qs + tp * 136 + part * 16), qb_ = *(const LAS u32x4*)(Qs + tp * 136 + part * 16 + 8), pp_ = *(const LAS u32x4*)(Ps + tp * 72 + part * 8);
              const f32x4 n0 = *(const LAS f32x4*)(nm + part * 16), n1 = *(const LAS f32x4*)(nm + part * 16 + 4), n2 = *(const LAS f32x4*)(nm + part * 16 + 8), n3 = *(const LAS f32x4*)(nm + part * 16 + 12);
              qn = (bflo(qa_.x) * n0[0] + bfhi(qa_.x) * n0[1]) + (bflo(qa_.y) * n0[2] + bfhi(qa_.y) * n0[3]) + (bflo(qa_.z) * n1[0] + bfhi(qa_.z) * n1[1]) + (bflo(qa_.w) * n1[2] + bfhi(qa_.w) * n1[3])
                 + (bflo(qb_.x) * n2[0] + bfhi(qb_.x) * n2[1]) + (bflo(qb_.y) * n2[2] + bfhi(qb_.y) * n2[3]) + (bflo(qb_.z) * n3[0] + bfhi(qb_.z) * n3[1]) + (bflo(qb_.w) * n3[2] + bfhi(qb_.w) * n3[3]);
              ds = (bflo(pp_.x) + bfhi(pp_.x)) + (bflo(pp_.y) + bfhi(pp_.y)) + (bflo(pp_.z) + bfhi(pp_.z)) + (bflo(pp_.w) + bfhi(pp_.w));
              qn += __shfl_xor(qn, 1); qn += __shfl_xor(qn, 2); qn += __shfl_xor(qn, 4); ds += __shfl_xor(ds, 1); ds += __shfl_xor(ds, 2); ds += __shfl_xor(ds, 4);
              if (part == 0) denl[tp] = G[128 + tp] * qn + ds; }
            { const int kp = tid >> 2, pp = tid & 3;
              const u32x4 ka_ = *(const LAS u32x4*)(KdT + kp * 72 + pp * 16), kb_ = *(const LAS u32x4*)(KdT + kp * 72 + pp * 16 + 8);
              float sm = ((bflo(ka_.x) + bfhi(ka_.x)) + (bflo(ka_.y) + bfhi(ka_.y))) + ((bflo(ka_.z) + bfhi(ka_.z)) + (bflo(ka_.w) + bfhi(ka_.w)))
                       + ((bflo(kb_.x) + bfhi(kb_.x)) + (bflo(kb_.y) + bfhi(kb_.y))) + ((bflo(kb_.z) + bfhi(kb_.z)) + (bflo(kb_.w) + bfhi(kb_.w)));
              sm += __shfl_xor(sm, 1); sm += __shfl_xor(sm, 2);
              nnew = sdecs[n & 1] * nm[kp] + sm; }
        }
        {
            const float cdec = sdecs[n & 1];
#pragma unroll
            for (int tn = 0; tn < 8; ++tn) Racc[tn] = Racc[tn] * cdec;
#pragma unroll
            for (int kk = 0; kk < 2; ++kk) { const bf16x8 a = ldfrag(KdT, 16 * wave + l16, 72, kk * 32 + quad * 8);
#pragma unroll
                for (int tn = 0; tn < 8; ++tn) { const bf16x8 bq = ldfrag(VT, 16 * tn + l16, 72, kk * 32 + quad * 8); Racc[tn] = MFMA16(a, bq, Racc[tn]); } }
        }
        if (MIX == 2 && wave == 0 && n + 1 < 32) SC_GATES(n + 1);
        __syncthreads();
#pragma unroll
        for (int tn = 0; tn < 8; ++tn) { u32x2 o; o.x = cvt_pk_bf16(Racc[tn][0], Racc[tn][1]); o.y = cvt_pk_bf16(Racc[tn][2], Racc[tn][3]); *(LAS u32x2*)(RT + (16 * tn + l16) * 136 + 16 * wave + 4 * quad) = o; }
        if (MIX == 2 && (tid & 3) == 0) nm[tid >> 2] = nnew;
        {
            const float ssqt = red[t * 2] + red[t * 2 + 1]; float rs;
            if (MIX == 1) rs = rsqrtf(ssqt * (1.0f / 128.0f) + 1e-6f);
            else { const float dd = fmaxf(fabsf(denl[t]), G[256 + t]); const float inv = 1.0f / dd; rs = inv * rsqrtf(ssqt * inv * inv * (1.0f / 128.0f) + 1e-6f); }
            bf16_t* gp = PROJ + (row0 + (size_t)n * 64 + t) * PW + colq + 1536;
#pragma unroll
            for (int i = 0; i < 4; ++i) { const int c0 = 16 * (tnb4 + i) + 4 * quad; const u32x2 gv = gpre[i]; float g4[4] = {bflo(gv.x), bfhi(gv.x), bflo(gv.y), bfhi(gv.y)}, r4[4];
                if (MIX == 1) {
#pragma unroll
                    for (int j = 0; j < 4; ++j) r4[j] = o2[i][j] * rs * siluf_(g4[j]); }
                else { const f32x4 nw = nwv[i];
#pragma unroll
                    for (int j = 0; j < 4; ++j) r4[j] = o2[i][j] * rs * nw[j] * sigmoidf_(g4[j]); }
                u32x2 ov; ov.x = cvt_pk_bf16(r4[0], r4[1]); ov.y = cvt_pk_bf16(r4[2], r4[3]); *(u32x2*)(gp + c0) = ov; }
        }
        if (n + 1 < 32) SC_STORE(n + 1);
    }
    {
        float* so = p.out() + (MIX == 1 ? O_PR : O_PC) + sidx * 16384;
#pragma unroll
        for (int tn = 0; tn < 8; ++tn)
#pragma unroll
            for (int j = 0; j < 4; ++j) so[(16 * wave + 4 * quad + j) * 128 + 16 * tn + l16] = Racc[tn][j];
    }
    __syncthreads();
    if (MIX == 2) { if (tid < 128) p.out()[O_PN + sidx * 128 + tid] = nm[tid]; if (tid == 0) p.out()[O_PM + sidx] = mm; }
    __syncthreads();
#undef SC_LOAD
#undef SC_GATES
#undef SC_STORE
}
__device__ void dn_prep_item(const DP& p, int l, int b, int n, int h, LAS unsigned char* lds) {
    lds = launder_lds(lds);
    const int tid = my_tid(), lane = tid & 63, wave = __builtin_amdgcn_readfirstlane(tid >> 6), l16 = lane & 15, quad = lane >> 4;
    const bf16_t* PROJ = (const bf16_t*)(p.ws() + WS_PROJ); const float* SM = (const float*)(p.ws() + WS_SMALL);
    LAS bf16_t* Kn = (LAS bf16_t*)(lds + 0); LAS bf16_t* Qn = (LAS bf16_t*)(lds + 17408); LAS float* MT = (LAS float*)(lds + 34816);
    LAS float* Vf = (LAS float*)(lds + 52224); LAS float* Kf = (LAS float*)(lds + 84992);
    LAS float* gcs = (LAS float*)(lds + 117760); LAS float* betas = gcs + 64; LAS float* egs = gcs + 128;
    LAS bf16_t* MB = (LAS bf16_t*)(lds + 118528);
    LAS bf16_t* XT = (LAS bf16_t*)(lds + 0);
    const size_t row0 = (size_t)b * SEQ + (size_t)n * 64;
    const int ci = (b * 4 + h) * 32 + n;
    unsigned char* aux = p.ws() + WS_AUX;
    __syncthreads();
    LAS float* cwl = MT;
    if (tid < 384) { const int wh_ = tid >> 7, cc_ = tid & 127; const float* cwp = p.in(I_CONVW) + (size_t)l * 4 * 1536 + wh_ * 512 + h * 128 + cc_;
#pragma unroll
        for (int j = 0; j < 4; ++j) cwl[(wh_ * 4 + j) * 128 + cc_] = cwp[j * 1536]; }
    if (wave == 0) {
        const size_t r = row0 + lane; const float beta = sigmoidf_(SM[r * 16 + h]);
        float gc = -__expf(p.in(I_ALOG)[l * 4 + h]) * softplusf_(SM[r * 16 + 4 + h] + p.in(I_DTB)[l * 4 + h]);
#pragma unroll
        for (int d = 1; d < 64; d <<= 1) { const float y = __shfl_up(gc, d); if (lane >= d) gc += y; }
        gcs[lane] = gc; betas[lane] = beta; egs[lane] = __expf(gc);
        if (lane == 63) ((float*)(aux + AUX_EG))[ci] = __expf(gc);
    }
    __syncthreads();
    const int t = tid >> 3, cg = tid & 7;
    float qv[16];
#pragma unroll
    for (int which = 0; which < 3; ++which) {
        const int gcol = which * 512 + h * 128 + cg * 16;
        float acc[16], xs[16];
#pragma unroll
        for (int e = 0; e < 16; ++e) { acc[e] = 0.f; xs[e] = 0.f; }
        u32x4 xa[4], xb[4];
#pragma unroll
        for (int j = 0; j < 4; ++j) { const int tok = n * 64 + t + j - 3; const int tokc = tok < 0 ? 0 : tok;
            const bf16_t* xp = PROJ + ((size_t)b * SEQ + tokc) * PW + gcol; xa[j] = *(const u32x4*)xp; xb[j] = *(const u32x4*)(xp + 8); }
#pragma unroll
        for (int j = 0; j < 4; ++j) { const int tok = n * 64 + t + j - 3; const float msk = tok >= 0 ? 1.0f : 0.0f;
            const LAS float* wp = cwl + (which * 4 + j) * 128 + cg * 16;
            const f32x4 w0 = *(const LAS f32x4*)wp, w1 = *(const LAS f32x4*)(wp + 4), w2 = *(const LAS f32x4*)(wp + 8), w3 = *(const LAS f32x4*)(wp + 12);
            const float xf[16] = {bflo(xa[j].x), bfhi(xa[j].x), bflo(xa[j].y), bfhi(xa[j].y), bflo(xa[j].z), bfhi(xa[j].z), bflo(xa[j].w), bfhi(xa[j].w), bflo(xb[j].x), bfhi(xb[j].x), bflo(xb[j].y), bfhi(xb[j].y), bflo(xb[j].z), bfhi(xb[j].z), bflo(xb[j].w), bfhi(xb[j].w)};
            const float wf[16] = {w0[0], w0[1], w0[2], w0[3], w1[0], w1[1], w1[2], w1[3], w2[0], w2[1], w2[2], w2[3], w3[0], w3[1], w3[2], w3[3]};
#pragma unroll
            for (int e = 0; e < 16; ++e) { acc[e] += xf[e] * (wf[e] * msk); if (j == 3) xs[e] = xf[e]; }
        }
        if (n == 31 && t >= 61) { float* co = p.out() + O_PCONV + ((size_t)(l * NB + b) * 3 + (t - 61)) * 1536 + gcol;
#pragma unroll
            for (int e = 0; e < 16; ++e) co[e] = xs[e]; }
        float ssq = 0.f;
#pragma unroll
        for (int e = 0; e < 16; ++e) { acc[e] = siluf_(acc[e]); ssq += acc[e] * acc[e]; }
        if (which < 2) { ssq += __shfl_xor(ssq, 1); ssq += __shfl_xor(ssq, 2); ssq += __shfl_xor(ssq, 4);
            const float sc = rsqrtf(ssq + 1e-6f) * (which == 0 ? DKS : 1.0f);
#pragma unroll
            for (int e = 0; e < 16; ++e) acc[e] *= sc; }
        if (which == 0) {
#pragma unroll
            for (int e = 0; e < 16; ++e) qv[e] = acc[e];
            u32x4 w; w.x = cvt_pk_bf16(acc[0], acc[1]); w.y = cvt_pk_bf16(acc[2], acc[3]); w.z = cvt_pk_bf16(acc[4], acc[5]); w.w = cvt_pk_bf16(acc[6], acc[7]); *(LAS u32x4*)(Qn + t * 136 + cg * 16) = w;
            w.x = cvt_pk_bf16(acc[8], acc[9]); w.y = cvt_pk_bf16(acc[10], acc[11]); w.z = cvt_pk_bf16(acc[12], acc[13]); w.w = cvt_pk_bf16(acc[14], acc[15]); *(LAS u32x4*)(Qn + t * 136 + cg * 16 + 8) = w;
        } else if (which == 1) {
            u32x4 w; w.x = cvt_pk_bf16(acc[0], acc[1]); w.y = cvt_pk_bf16(acc[2], acc[3]); w.z = cvt_pk_bf16(acc[4], acc[5]); w.w = cvt_pk_bf16(acc[6], acc[7]); *(LAS u32x4*)(Kn + t * 136 + cg * 16) = w;
            w.x = cvt_pk_bf16(acc[8], acc[9]); w.y = cvt_pk_bf16(acc[10], acc[11]); w.z = cvt_pk_bf16(acc[12], acc[13]); w.w = cvt_pk_bf16(acc[14], acc[15]); *(LAS u32x4*)(Kn + t * 136 + cg * 16 + 8) = w;
#pragma unroll
            for (int q4 = 0; q4 < 4; ++q4) *(LAS f32x4*)(Kf + t * 128 + cg * 16 + q4 * 4) = (f32x4){acc[q4 * 4], acc[q4 * 4 + 1], acc[q4 * 4 + 2], acc[q4 * 4 + 3]};
        } else {
#pragma unroll
            for (int q4 = 0; q4 < 4; ++q4) *(LAS f32x4*)(Vf + t * 128 + cg * 16 + q4 * 4) = (f32x4){acc[q4 * 4], acc[q4 * 4 + 1], acc[q4 * 4 + 2], acc[q4 * 4 + 3]};
        }
    }
    __syncthreads();
    { const float eg = egs[t]; bf16_t* o = (bf16_t*)(aux + AUX_QG) + (size_t)ci * 8192 + t * 128 + cg * 16;
      u32x4 w; w.x = cvt_pk_bf16(qv[0] * eg, qv[1] * eg); w.y = cvt_pk_bf16(qv[2] * eg, qv[3] * eg); w.z = cvt_pk_bf16(qv[4] * eg, qv[5] * eg); w.w = cvt_pk_bf16(qv[6] * eg, qv[7] * eg); *(u32x4*)o = w;
      w.x = cvt_pk_bf16(qv[8] * eg, qv[9] * eg); w.y = cvt_pk_bf16(qv[10] * eg, qv[11] * eg); w.z = cvt_pk_bf16(qv[12] * eg, qv[13] * eg); w.w = cvt_pk_bf16(qv[14] * eg, qv[15] * eg); *(u32x4*)(o + 8) = w; }
    { const int k = tid >> 2, sq = tid & 3; const float gl = gcs[63]; float vals[16];
#pragma unroll
      for (int e = 0; e < 16; ++e) { const int s = sq * 16 + e; vals[e] = Kf[s * 128 + k] * __expf(gl - gcs[s]); }
      bf16_t* o = (bf16_t*)(aux + AUX_KDT) + (size_t)ci * 8192 + k * 64 + sq * 16;
      u32x4 w; w.x = cvt_pk_bf16(vals[0], vals[1]); w.y = cvt_pk_bf16(vals[2], vals[3]); w.z = cvt_pk_bf16(vals[4], vals[5]); w.w = cvt_pk_bf16(vals[6], vals[7]); *(u32x4*)o = w;
      w.x = cvt_pk_bf16(vals[8], vals[9]); w.y = cvt_pk_bf16(vals[10], vals[11]); w.z = cvt_pk_bf16(vals[12], vals[13]); w.w = cvt_pk_bf16(vals[14], vals[15]); *(u32x4*)(o + 8) = w; }
    {
        const int tm = wave >> 1, tnb = (wave & 1) * 2;
        f32x4 kk[2] = {(f32x4){0.f, 0.f, 0.f, 0.f}, (f32x4){0.f, 0.f, 0.f, 0.f}}, qk[2] = {(f32x4){0.f, 0.f, 0.f, 0.f}, (f32x4){0.f, 0.f, 0.f, 0.f}};
#pragma unroll
        for (int kx = 0; kx < 4; ++kx) { const bf16x8 ak = ldfrag(Kn, 16 * tm + l16, 136, kx * 32 + quad * 8), aq = ldfrag(Qn, 16 * tm + l16, 136, kx * 32 + quad * 8);
#pragma unroll
            for (int i = 0; i < 2; ++i) { const bf16x8 bk = ldfrag(Kn, 16 * (tnb + i) + l16, 136, kx * 32 + quad * 8); kk[i] = MFMA16(ak, bk, kk[i]); qk[i] = MFMA16(bk, aq, qk[i]); } }
#pragma unroll
        for (int i = 0; i < 2; ++i) {
            { const int s = 16 * (tnb + i) + l16; const float gs = gcs[s]; f32x4 m;
#pragma unroll
              for (int j = 0; j < 4; ++j) { const int tt = 16 * tm + 4 * quad + j; m[j] = tt > s ? betas[tt] * kk[i][j] * __expf(gcs[tt] - gs) : 0.f; }
              *(LAS f32x4*)(MT + s * 68 + 16 * tm + 4 * quad) = m;
#pragma unroll
              for (int j = 0; j < 4; ++j) MB[(16 * tm + 4 * quad + j) * 72 + s] = f2bf(m[j]); }
            { const int tt = 16 * tm + l16, s0 = 16 * (tnb + i) + 4 * quad; const float gt_ = gcs[tt]; float w4[4];
#pragma unroll
              for (int j = 0; j < 4; ++j) { const int s = s0 + j; w4[j] = s <= tt ? qk[i][j] * __expf(gt_ - gcs[s]) : 0.f; }
              u32x2 o; o.x = cvt_pk_bf16(w4[0], w4[1]); o.y = cvt_pk_bf16(w4[2], w4[3]); *(u32x2*)((bf16_t*)(aux + AUX_QK) + (size_t)ci * 4096 + tt * 64 + s0) = o; }
        }
    }
    __syncthreads();
    { const float bt = betas[t], be = bt * egs[t];
#pragma unroll
      for (int q4 = 0; q4 < 4; ++q4) { LAS f32x4* vp = (LAS f32x4*)(Vf + t * 128 + cg * 16 + q4 * 4); *vp = *vp * bt; LAS f32x4* kp = (LAS f32x4*)(Kf + t * 128 + cg * 16 + q4 * 4); *kp = *kp * be; } }
    __syncthreads();
#pragma unroll
    for (int ib = 0; ib < 4; ++ib) {
        if (tid < 256) {
            const int c = tid; const LAS float* R = c < 128 ? Vf + c : Kf + (c - 128); float r[16];
#pragma unroll
            for (int j = 0; j < 16; ++j) r[j] = R[(16 * ib + j) * 128];
#pragma unroll
            for (int s = 0; s < 15; ++s) {
#pragma unroll
                for (int v4 = (s + 1) >> 2; v4 < 4; ++v4) { const f32x4 mv = *(const LAS f32x4*)(MT + (16 * ib + s) * 68 + 16 * ib + 4 * v4);
#pragma unroll
                    for (int e = 0; e < 4; ++e) { const int tt = 4 * v4 + e; if (tt > s) r[tt] -= mv[e] * r[s]; } }
            }
            u32x4 w0, w1; w0.x = cvt_pk_bf16(r[0], r[1]); w0.y = cvt_pk_bf16(r[2], r[3]); w0.z = cvt_pk_bf16(r[4], r[5]); w0.w = cvt_pk_bf16(r[6], r[7]);
            w1.x = cvt_pk_bf16(r[8], r[9]); w1.y = cvt_pk_bf16(r[10], r[11]); w1.z = cvt_pk_bf16(r[12], r[13]); w1.w = cvt_pk_bf16(r[14], r[15]);
            if (c < 128) { bf16_t* o = (bf16_t*)(aux + AUX_UT) + (size_t)ci * 8192 + c * 64 + 16 * ib; *(u32x4*)o = w0; *(u32x4*)(o + 8) = w1; }
            else { bf16_t* o = (bf16_t*)(aux + AUX_W) + (size_t)ci * 8192 + (size_t)(16 * ib) * 128 + (c - 128);
#pragma unroll
                for (int j = 0; j < 16; ++j) o[j * 128] = f2bf(r[j]); }
            if (ib < 3) { *(LAS u32x4*)(XT + c * 64 + 16 * ib) = w0; *(LAS u32x4*)(XT + c * 64 + 16 * ib + 8) = w1; }
        }
        if (ib < 3) {
            __syncthreads();
#pragma unroll
            for (int q = 0; q < 2 * (3 - ib); ++q) { const int T = wave + 8 * q, tr = T >> 4, tc = T & 15;
                bf16x8 a = (bf16x8){0, 0, 0, 0, 0, 0, 0, 0}, bq = (bf16x8){0, 0, 0, 0, 0, 0, 0, 0};
                if (quad < 2) { a = ldfrag(MB, 16 * (ib + 1 + tr) + l16, 72, 16 * ib + quad * 8); bq = *(const LAS bf16x8*)(XT + (16 * tc + l16) * 64 + 16 * ib + quad * 8); }
                const f32x4 acc = MFMA16(a, bq, ((f32x4){0.f, 0.f, 0.f, 0.f}));
                LAS float* R = tc < 8 ? Vf + 16 * tc + l16 : Kf + 16 * (tc - 8) + l16;
#pragma unroll
                for (int j = 0; j < 4; ++j) R[(16 * (ib + 1 + tr) + 4 * quad + j) * 128] -= acc[j]; }
            __syncthreads();
        }
    }
}

__device__ void dn_scan_item(const DP& p, int l, int b, int h, LAS unsigned char* lds) {
    lds = launder_lds(lds);
    const int tid = my_tid(), lane = tid & 63, wave = __builtin_amdgcn_readfirstlane(tid >> 6), l16 = lane & 15, quad = lane >> 4;
    bf16_t* PROJ = (bf16_t*)(p.ws() + WS_PROJ); const unsigned char* aux = p.ws() + WS_AUX;
    LAS bf16_t* Ws = (LAS bf16_t*)(lds + 0); LAS bf16_t* QGs = (LAS bf16_t*)(lds + 17408); LAS bf16_t* QKs = (LAS bf16_t*)(lds + 34816);
    LAS bf16_t* KDTs = (LAS bf16_t*)(lds + 44032); LAS bf16_t* VnT = (LAS bf16_t*)(lds + 62464); LAS bf16_t* ST = (LAS bf16_t*)(lds + 80896);
    LAS float* red = (LAS float*)(lds + 115712);
    const size_t row0 = (size_t)b * SEQ; const size_t sidx = (size_t)(l * NB + b) * 4 + h; const int ci0 = (b * 4 + h) * 32;
    __syncthreads();
    for (int i = tid; i < 128 * 136 / 2; i += 512) ((LAS unsigned*)ST)[i] = 0u;
    f32x4 Sacc[8];
#pragma unroll
    for (int i = 0; i < 8; ++i) Sacc[i] = (f32x4){0.f, 0.f, 0.f, 0.f};
    const int tm = wave >> 1, tnb4 = (wave & 1) * 4;
    f32x4 nwv[4];
#pragma unroll
    for (int i = 0; i < 4; ++i) nwv[i] = *(const f32x4*)(p.in(I_DNW) + l * 128 + 16 * (tnb4 + i) + 4 * quad);
    u32x4 w1, w2, g1, g2, k1, k2, qk1; u32x2 ut[4]; float eg = 1.f;
#define DN_LOAD(n_) do { const size_t ci_ = (size_t)(ci0 + (n_)); \
        const bf16_t* wg = (const bf16_t*)(aux + AUX_W) + ci_ * 8192; w1 = *(const u32x4*)(wg + tid * 8); w2 = *(const u32x4*)(wg + (tid + 512) * 8); \
        const bf16_t* qg = (const bf16_t*)(aux + AUX_QG) + ci_ * 8192; g1 = *(const u32x4*)(qg + tid * 8); g2 = *(const u32x4*)(qg + (tid + 512) * 8); \
        const bf16_t* kd = (const bf16_t*)(aux + AUX_KDT) + ci_ * 8192; k1 = *(const u32x4*)(kd + tid * 8); k2 = *(const u32x4*)(kd + (tid + 512) * 8); \
        qk1 = *(const u32x4*)((const bf16_t*)(aux + AUX_QK) + ci_ * 4096 + tid * 8); \
        const bf16_t* ug = (const bf16_t*)(aux + AUX_UT) + ci_ * 8192; \
        _Pragma("unroll") for (int i = 0; i < 4; ++i) ut[i] = *(const u32x2*)(ug + (16 * (tnb4 + i) + l16) * 64 + 16 * tm + 4 * quad); \
        eg = ((const float*)(aux + AUX_EG))[ci_]; } while (0)
#define DN_STORE() do { \
        *(LAS u32x4*)(Ws + (tid >> 4) * 136 + (tid & 15) * 8) = w1; *(LAS u32x4*)(Ws + ((tid + 512) >> 4) * 136 + (tid & 15) * 8) = w2; \
        *(LAS u32x4*)(QGs + (tid >> 4) * 136 + (tid & 15) * 8) = g1; *(LAS u32x4*)(QGs + ((tid + 512) >> 4) * 136 + (tid & 15) * 8) = g2; \
        *(LAS u32x4*)(KDTs + (tid >> 3) * 72 + (tid & 7) * 8) = k1; *(LAS u32x4*)(KDTs + ((tid + 512) >> 3) * 72 + (tid & 7) * 8) = k2; \
        *(LAS u32x4*)(QKs + (tid >> 3) * 72 + (tid & 7) * 8) = qk1; } while (0)
    DN_LOAD(0);
    DN_STORE();
    const int t = 16 * tm + l16;
    for (int n = 0; n < 32; ++n) {
        __syncthreads();
        const float egc = eg; u32x2 utc[4];
#pragma unroll
        for (int i = 0; i < 4; ++i) utc[i] = ut[i];
        if (n + 1 < 32) DN_LOAD(n + 1);
        u32x2 gpre[4];
        { const bf16_t* gp_ = PROJ + (row0 + (size_t)n * 64 + t) * PW + 1536 + h * 128;
#pragma unroll
          for (int i = 0; i < 4; ++i) gpre[i] = *(const u32x2*)(gp_ + 16 * (tnb4 + i) + 4 * quad); }
        {
            f32x4 acc[4];
#pragma unroll
            for (int i = 0; i < 4; ++i) acc[i] = (f32x4){0.f, 0.f, 0.f, 0.f};
#pragma unroll
            for (int kx = 0; kx < 4; ++kx) { const bf16x8 a = ldfrag(Ws, 16 * tm + l16, 136, kx * 32 + quad * 8);
#pragma unroll
                for (int i = 0; i < 4; ++i) { const bf16x8 bq = ldfrag(ST, 16 * (tnb4 + i) + l16, 136, kx * 32 + quad * 8); acc[i] = MFMA16(a, bq, acc[i]); } }
#pragma unroll
            for (int i = 0; i < 4; ++i) { const float v0 = bflo(utc[i].x) - acc[i][0], v1 = bfhi(utc[i].x) - acc[i][1], v2 = bflo(utc[i].y) - acc[i][2], v3 = bfhi(utc[i].y) - acc[i][3];
                u32x2 o; o.x = cvt_pk_bf16(v0, v1); o.y = cvt_pk_bf16(v2, v3); *(LAS u32x2*)(VnT + (16 * (tnb4 + i) + l16) * 72 + 16 * tm + 4 * quad) = o; }
        }
        __syncthreads();
        f32x4 o2[4];
        {
#pragma unroll
            for (int i = 0; i < 4; ++i) o2[i] = (f32x4){0.f, 0.f, 0.f, 0.f};
#pragma unroll
            for (int kx = 0; kx < 4; ++kx) { const bf16x8 a = ldfrag(QGs, t, 136, kx * 32 + quad * 8);
#pragma unroll
                for (int i = 0; i < 4; ++i) { const bf16x8 bq = ldfrag(ST, 16 * (tnb4 + i) + l16, 136, kx * 32 + quad * 8); o2[i] = MFMA16(bq, a, o2[i]); } }
#pragma unroll
            for (int kx = 0; kx < 2; ++kx) { const bf16x8 a = ldfrag(QKs, t, 72, kx * 32 + quad * 8);
#pragma unroll
                for (int i = 0; i < 4; ++i) { const bf16x8 bq = ldfrag(VnT, 16 * (tnb4 + i) + l16, 72, kx * 32 + quad * 8); o2[i] = MFMA16(bq, a, o2[i]); } }
            float ssq = 0.f;
#pragma unroll
            for (int i = 0; i < 4; ++i) ssq += (o2[i][0] * o2[i][0] + o2[i][1] * o2[i][1]) + (o2[i][2] * o2[i][2] + o2[i][3] * o2[i][3]);
            ssq += __shfl_xor(ssq, 16); ssq += __shfl_xor(ssq, 32);
            if (quad == 0) red[t * 2 + (wave & 1)] = ssq;
        }
        {
#pragma unroll
            for (int tn = 0; tn < 8; ++tn) Sacc[tn] = Sacc[tn] * egc;
#pragma unroll
            for (int kx = 0; kx < 2; ++kx) { const bf16x8 a = ldfrag(KDTs, 16 * wave + l16, 72, kx * 32 + quad * 8);
#pragma unroll
                for (int tn = 0; tn < 8; ++tn) { const bf16x8 bq = ldfrag(VnT, 16 * tn + l16, 72, kx * 32 + quad * 8); Sacc[tn] = MFMA16(a, bq, Sacc[tn]); } }
        }
        __syncthreads();
#pragma unroll
        for (int tn = 0; tn < 8; ++tn) { u32x2 o; o.x = cvt_pk_bf16(Sacc[tn][0], Sacc[tn][1]); o.y = cvt_pk_bf16(Sacc[tn][2], Sacc[tn][3]); *(LAS u32x2*)(ST + (16 * tn + l16) * 136 + 16 * wave + 4 * quad) = o; }
        {
            const float rs = rsqrtf((red[t * 2] + red[t * 2 + 1]) * (1.0f / 128.0f) + 1e-6f);
            bf16_t* gp = PROJ + (row0 + (size_t)n * 64 + t) * PW + 1536 + h * 128;
#pragma unroll
            for (int i = 0; i < 4; ++i) { const int c0 = 16 * (tnb4 + i) + 4 * quad; const u32x2 gv = gpre[i]; const float g4[4] = {bflo(gv.x), bfhi(gv.x), bflo(gv.y), bfhi(gv.y)};
                const f32x4 nw = nwv[i]; float r4[4];
#pragma unroll
                for (int j = 0; j < 4; ++j) r4[j] = o2[i][j] * rs * nw[j] * siluf_(g4[j]);
                u32x2 ov; ov.x = cvt_pk_bf16(r4[0], r4[1]); ov.y = cvt_pk_bf16(r4[2], r4[3]); *(u32x2*)(gp + c0) = ov; }
        }
        if (n + 1 < 32) DN_STORE();
    }
    {
        float* so = p.out() + O_PS + sidx * 16384;
#pragma unroll
        for (int tn = 0; tn < 8; ++tn)
#pragma unroll
            for (int j = 0; j < 4; ++j) so[(16 * wave + 4 * quad + j) * 128 + 16 * tn + l16] = Sacc[tn][j];
    }
    __syncthreads();
#undef DN_LOAD
#undef DN_STORE
}
#define XB_TMO      128
#define XB_XCNT(j)  (256  + 64 * (j))
#define XB_XSUB(j)  (1280 + 64 * (j))
#define XB_XGEN(j)  (2304 + 64 * (j))
#define XB_TOP      3328
#define XB_TOPGEN   3392
#define XCD_BAR_WORDS 3456
#define XB_SPIN_CAP (1u << 18)

__device__ __forceinline__ unsigned xb_ld(unsigned* p)              { return __hip_atomic_load(p, __ATOMIC_RELAXED, __HIP_MEMORY_SCOPE_AGENT); }
__device__ __forceinline__ unsigned xb_add(unsigned* p, unsigned v) { return __hip_atomic_fetch_add(p, v, __ATOMIC_RELAXED, __HIP_MEMORY_SCOPE_AGENT); }
__device__ __forceinline__ unsigned xb_xcc_id() { return (unsigned)__builtin_amdgcn_s_getreg((3 << 11) | 20) & 0xFu; }
#define XB_SPIN(cond, bar) do { unsigned _sp = 0; while (cond) { __builtin_amdgcn_s_sleep(1); \
    if ((++_sp & 255u) == 0u) { if (xb_ld(&(bar)[XB_TMO])) break; if (_sp > XB_SPIN_CAP) { atomicAdd(&(bar)[XB_TMO], 1u); break; } } } } while (0)

struct XcdBarrier {
    unsigned* bar; unsigned x;
    volatile LAS unsigned* st;
};

__device__ __forceinline__ XcdBarrier xcd_barrier_post(unsigned* bar, volatile LAS unsigned* st) {
    XcdBarrier b; b.bar = bar; b.x = xb_xcc_id(); b.st = st;
    if (threadIdx.x == 0) (void)xb_add(&bar[XB_XCNT(b.x)], 1u);
    return b;
}
__device__ __forceinline__ void xcd_barrier_complete(unsigned* bar, unsigned x, unsigned& nloc, unsigned& nx) {
    const unsigned G = gridDim.x * gridDim.y * gridDim.z;
    unsigned sum, cnt, mine, sp = 0u;
    for (;;) {
        sum = 0u; cnt = 0u; mine = 0u;
#pragma unroll
        for (unsigned j = 0; j < 16; ++j) { const unsigned c = xb_ld(&bar[XB_XCNT(j)]); sum += c; cnt += (c > 0u) ? 1u : 0u; mine = (j == x) ? c : mine; }
        if (sum == G) break;
        __builtin_amdgcn_s_sleep(1);
        if ((++sp & 255u) == 0u) { if (xb_ld(&bar[XB_TMO])) break; if (sp > XB_SPIN_CAP) { atomicAdd(&bar[XB_TMO], 1u); break; } }
    }
    nloc = mine > 0u ? mine : 1u; nx = cnt > 0u ? cnt : 1u;
}

__device__ __forceinline__ void xcd_barrier(const XcdBarrier& b) {
    asm volatile("s_waitcnt vmcnt(0)" ::: "memory");
    __syncthreads();
    if (threadIdx.x == 0) {
        unsigned* bar = b.bar;
        __builtin_amdgcn_s_waitcnt(0);
        unsigned nloc = b.st[0], nx = b.st[1];
        if (nloc == 0u) { xcd_barrier_complete(bar, b.x, nloc, nx); b.st[0] = nloc; b.st[1] = nx; }
        const unsigned old = xb_add(&bar[XB_XSUB(b.x)], 1u);
        const unsigned gen = old / nloc;
        if (old + 1u == (gen + 1u) * nloc) {
            __builtin_amdgcn_fence(__ATOMIC_RELEASE, "agent");
            asm volatile("s_waitcnt vmcnt(0)" ::: "memory");
            const unsigned og = xb_add(&bar[XB_TOP], 1u);
            const unsigned tg = og / nx;
            if (og + 1u == (tg + 1u) * nx) xb_add(&bar[XB_TOPGEN], 1u);
            else XB_SPIN(xb_ld(&bar[XB_TOPGEN]) == tg, bar);
            __builtin_amdgcn_fence(__ATOMIC_ACQUIRE, "agent");
            xb_add(&bar[XB_XGEN(b.x)], 1u);
            asm volatile("s_waitcnt vmcnt(0)" ::: "memory");
        } else {
            XB_SPIN(xb_ld(&bar[XB_XGEN(b.x)]) == gen, bar);
            __builtin_amdgcn_fence(__ATOMIC_ACQUIRE, "agent");
            asm volatile("s_waitcnt vmcnt(0)" ::: "memory");
        }
    }
    __syncthreads();
}

__device__ __forceinline__ int next_item(unsigned* ctr, LAS int* slot) {
    __syncthreads();
    if (my_tid() == 0) *slot = (int)atomicAdd(ctr, 1u);
    __syncthreads();
    return __builtin_amdgcn_readfirstlane(*slot);
}

__device__ void run_phase(int ph, LAS unsigned char* lds) {
    lds = launder_lds(lds);
    DP p{(const LAS unsigned long long*)(lds + MISC_OFF + 64)};
    const int G = gridDim.x, bx = my_bid();
    bf16_t* X = (bf16_t*)(p.ws() + WS_X); bf16_t* PROJ = (bf16_t*)(p.ws() + WS_PROJ); bf16_t* MG = (bf16_t*)(p.ws() + WS_AUX); bf16_t* H = (bf16_t*)(p.ws() + WS_AUX);
    bf16_t* T1 = (bf16_t*)(p.ws() + WS_PROJ); bf16_t* U = (bf16_t*)(p.ws() + WS_PROJ); bf16_t* T2 = (bf16_t*)(p.ws() + WS_PROJ + OFF_T2);
    unsigned* ctr = (unsigned*)(p.ws() + WS_CTR); float* TS1 = (float*)(p.ws() + WS_AUX + (size_t)36 * 1024 * 1024); bf16_t* PZ = (bf16_t*)(p.ws() + WS_AUX + (size_t)62 * 1024 * 1024); float* TS2 = (float*)(p.ws() + WS_TS2);
    if (ph == 0) { phase_prep(p, lds); return; }
    const int l = (ph - 1) / 9, s = (ph - 1) % 9;
    const bf16_t* WinT = (const bf16_t*)(p.ws() + WS_WIN) + (size_t)l * 9216 * 1024;
    if (s == 0) {
        pg8::Gemm g{X, WinT, NTOK, PW, DM, DM, 0, 0, DM}; pg8::Order S; S.init(NTOK, PW, 1, G, bx, DM);
        pg8::EpiBf16<0> E{PROJ, PW};
        pg8::gemm_phase(lds, g, S, E);
        phase_small(p, l, lds);
    } else if (s == 1) {
        LAS int* slot = (LAS int*)(lds + MISC_OFF);
        for (;;) {
            const int it = next_item(ctr + l * 4, slot);
            if (it >= 1024) break;
            dn_prep_item(p, l, it >> 7, (it >> 2) & 31, it & 3, lds);
        }
    } else if (s == 2) {
        if (bx < 32) scan_item<2>(p, l, bx >> 2, bx & 3, lds);
        else if (bx < 64) scan_item<1>(p, l, (bx - 32) >> 2, bx & 3, lds);
        else if (bx < 96) dn_scan_item(p, l, (bx - 64) >> 2, bx & 3, lds);
        else {
            pg8::Gemm g{X, WinT + (size_t)PW * 1024, NTOK, NG, DM, DM, 0, 0, DM}; pg8::Order S; S.init(NTOK, NG, 1, G - 96, bx - 96, DM);
            pg8::EpiGateU8 E{(unsigned char*)PROJ, p.ws() + WS_SGS};
            pg8::gemm_phase(lds, g, S, E);
        }
        { LAS int* slot = (LAS int*)(lds + MISC_OFF);
          for (;;) {
            const int j = next_item(ctr + l * 4 + 1, slot);
            if (j >= 1536) break;
            const int mix = j / 512, rem = j % 512, b = rem >> 2, h = rem & 3;
            if (mix == 0) rec_item<0>(p, l, false, b, h, lds); else if (mix == 1) rec_item<1>(p, l, false, b, h, lds); else rec_item<2>(p, l, false, b, h, lds);
           }
          if (l + 1 < NL) for (;;) {
            const int i = next_item(ctr + l * 4 + 2, slot);
            if (i >= 4992) break;
            prep_one_tile(p, layer_tile(l + 1, i), lds);
          } }
    } else if (s == 3) {
        pg8::Gemm g{PROJ + 1536, (const bf16_t*)(p.ws() + WS_WBR) + (size_t)l * 3 * 1024 * 512, NTOK, DM, 512, PW, 2048, 1024 * 512, 512}; pg8::Order S; S.init(NTOK, DM, 3, G, bx, 512, G == 256 ? -1 : 0);
        pg8::EpiMerge E{(const unsigned char*)PROJ, p.ws() + WS_SGS, MG, PZ};
        pg8::gemm_phase(lds, g, S, E);
    } else if (s == 4) {
        pg8::Gemm g{MG, (const bf16_t*)(p.ws() + WS_WOUT) + (size_t)l * 1024 * 1024, NTOK, DM, DM, DM, DM / 4, DM / 4, DM, PZ, 512 * 1024, 4}; pg8::Order S; S.init(NTOK, DM, 1, G, bx, DM, G == 256 ? 12 : 0, 4);
        pg8::EpiRes E{X, T1, TS1};
        pg8::gemm_phase(lds, g, S, E);
    } else if (s == 5) {
        phase_ln(T1, TS1, G == 256 ? 12 : 0, p.in(I_LN1G) + l * DM, p.in(I_LN1B) + l * DM, H, nullptr, nullptr);
    } else if (s == 6) {
        pg8::Gemm g{H, (const bf16_t*)(p.ws() + WS_WFF1) + (size_t)l * 4096 * 1024, NTOK, DFF, DM, DM, 0, 0, DM}; pg8::Order S; S.init(NTOK, DFF, 1, G, bx, DM);
        pg8::EpiBf16<1> E{U, DFF};
        pg8::gemm_phase(lds, g, S, E);
    } else if (s == 7) {
        pg8::Gemm g{U, (const bf16_t*)(p.ws() + WS_WFF2) + (size_t)l * 1024 * 4096, NTOK, DM, DFF, DFF, DFF / 8, DFF / 8, DFF, U + (size_t)NP * DFF, 0, 8}; pg8::Order S; S.init(NTOK, DM, 1, G, bx, DFF, G == 256 ? 8 : 0, 8);
        pg8::EpiRes E{H, T2, TS2};
        pg8::gemm_phase(lds, g, S, E);
    } else {
        const bool lastl = (l == NL - 1);
        phase_ln(T2, TS2, G == 256 ? 8 : 0, p.in(I_LN2G) + l * DM, p.in(I_LN2B) + l * DM, X, lastl ? p.out() + O_YP : nullptr, lastl ? p.out() + O_YS : nullptr);
    }
}

constexpr int NPHASE = 1 + 9 * NL;
__global__ void __launch_bounds__(512) mega(Params kp, int ph_lo, int ph_hi) {
    extern __shared__ __attribute__((aligned(16))) unsigned char lds_raw[];
    LAS unsigned char* lds = (LAS unsigned char*)lds_raw;
    cg::grid_group grid = cg::this_grid();
    LAS unsigned long long* tab = (LAS unsigned long long*)(lds + MISC_OFF + 64);
    if (threadIdx.x == 0) {
#pragma unroll
        for (int i = 0; i < 26; ++i) tab[i] = (unsigned long long)kp.in[i];
        tab[26] = (unsigned long long)kp.out; tab[27] = (unsigned long long)kp.ws; }
    if (threadIdx.x < 4) ((LAS unsigned*)(lds + MISC_OFF + 16))[threadIdx.x] = 0u;
    __syncthreads();
    const XcdBarrier xb = xcd_barrier_post((unsigned*)(kp.ws + WS_CTR + 1024), (volatile LAS unsigned*)(lds + MISC_OFF + 16));
    for (int ph = ph_lo; ph < ph_hi; ++ph) {
        run_phase(ph, lds);
        if (ph + 1 < ph_hi) {
            if (ph == ph_lo) grid.sync();
            else xcd_barrier(xb);
        }
    }
}

extern "C" void kernel_launch(void* const* d_in, const int* in_sizes, int n_in, void* d_out, int out_size, void* d_ws, size_t ws_size, hipStream_t stream) {
    static int grid = 0;
    if (grid == 0) {
        int dev = 0, cus = 0, per_cu = 0;
        (void)hipGetDevice(&dev);
        (void)hipDeviceGetAttribute(&cus, hipDeviceAttributeMultiprocessorCount, dev);
        (void)hipFuncSetAttribute((const void*)mega, hipFuncAttributeMaxDynamicSharedMemorySize, LDS_BYTES);
        (void)hipOccupancyMaxActiveBlocksPerMultiprocessor(&per_cu, (const void*)mega, 512, LDS_BYTES);
        if (per_cu < 1) per_cu = 1;
        grid = cus * per_cu;
        if (n_in != 26 || (long)out_size != O_END || ws_size < WS_END) { fprintf(stderr, "kernel_launch: unexpected sizes n_in %d out %d ws %zu (need %zu)\n", n_in, out_size, ws_size, (size_t)WS_END); }
    }
    (void)hipMemsetAsync((char*)d_ws + WS_CTR, 0, SZ_CTR, stream);
    Params p{};
    for (int i = 0; i < 26; ++i) p.in[i] = (const float*)d_in[i];
    p.out = (float*)d_out; p.ws = (unsigned char*)d_ws;
    int lo = 0, hi = NPHASE;
    void* args[] = {&p, &lo, &hi};
    hipError_t e = hipLaunchCooperativeKernel((const void*)mega, dim3(grid), dim3(512), args, LDS_BYTES, stream);
    if (e != hipSuccess) fprintf(stderr, "cooperative launch failed: %s (grid %d)\n", hipGetErrorString(e), grid);
}
```
